# Optimizing an MI355X kernel written in HIP

```python
import jax, jax.numpy as jnp
from jax import lax
import numpy as np

D_MODEL = 1024
BATCH = 16
SEQ = 2048
DEPTH = 2

MIX_WIDTH = D_MODEL
MLSTM_WIDTH = D_MODEL // 2
MLSTM_HEADS = 4
MLSTM_HEAD_DIM = MLSTM_WIDTH // MLSTM_HEADS
CHUNK = 64
CONV_WIDTH = 4
POOL_WIDTH = MIX_WIDTH - MLSTM_WIDTH
POOL_WINDOWS = (2, 4, 8, 16)
POOL_GROUP = POOL_WIDTH // len(POOL_WINDOWS)
N_IN = 4 * MLSTM_WIDTH + 2 * MLSTM_HEADS + POOL_WIDTH
MEM_LEN = 256
XATTN_HEADS = 4
XATTN_HEAD_DIM = D_MODEL // XATTN_HEADS
N_EXPERTS = 16
N_GROUPS = 4
EXPERTS_PER_GROUP = N_EXPERTS // N_GROUPS
TOP_K = 2
D_EXPERT = D_MODEL // 4
MOE_BLOCK = 128
DEEPNORM_ALPHA = (2 * DEPTH) ** 0.25
DEEPNORM_BETA = (8 * DEPTH) ** -0.25
LN_EPS = 1e-5

kernel_name = "hybrid_mlstm_pool_memxattn_groupmoe_deepnorm"


def layer_norm(x, g, b):
    xf = x.astype(jnp.float32)
    mu = xf.mean(-1, keepdims=True)
    var = jnp.square(xf - mu).mean(-1, keepdims=True)
    return ((xf - mu) * lax.rsqrt(var + LN_EPS) * g + b).astype(x.dtype)


def causal_depthwise_conv(u, w):
    S = u.shape[1]
    K = w.shape[0]
    up = jnp.pad(u, ((0, 0), (K - 1, 0), (0, 0)))
    return sum(up[:, j:j + S] * w[j] for j in range(K))


def mlstm_chunkwise(q, k, v, i_pre, f_pre):
    B, S, H, dh = q.shape
    L = CHUNK
    NC = S // L

    def chunk(t):
        t = t.reshape((B, NC, L, H) + t.shape[3:])
        return jnp.moveaxis(t, 3, 1)

    q = chunk(q.astype(jnp.float32)) * dh ** -0.5
    k = chunk(k.astype(jnp.float32))
    v = chunk(v.astype(jnp.float32))
    ig = chunk(i_pre.astype(jnp.float32))
    b = jnp.cumsum(jax.nn.log_sigmoid(chunk(f_pre.astype(jnp.float32))), axis=-1)
    b_last = b[..., -1]

    w_state = b_last[..., None] - b + ig
    m_loc = w_state.max(-1)
    a = jnp.exp(w_state - m_loc[..., None])
    C_loc = jnp.einsum('bhcl,bhcld,bhcle->bhcde', a, k, v)
    n_loc = jnp.einsum('bhcl,bhcld->bhcd', a, k)

    def step(carry, inp):
        C, n, m = carry
        Cl, nl, ml, bl = inp
        m_new = jnp.maximum(bl + m, ml)
        s_old = jnp.exp(bl + m - m_new)
        s_new = jnp.exp(ml - m_new)
        C_new = s_old[..., None, None] * C + s_new[..., None, None] * Cl
        n_new = s_old[..., None] * n + s_new[..., None] * nl
        return (C_new, n_new, m_new), (C, n, m)

    init = (jnp.zeros((B, H, dh, dh), jnp.float32),
            jnp.zeros((B, H, dh), jnp.float32),
            jnp.zeros((B, H), jnp.float32))
    xs = tuple(jnp.moveaxis(t, 2, 0) for t in (C_loc, n_loc, m_loc, b_last))
    _, (C_prev, n_prev, m_prev) = lax.scan(step, init, xs)
    C_prev = jnp.moveaxis(C_prev, 0, 2)
    n_prev = jnp.moveaxis(n_prev, 0, 2)
    m_prev = jnp.moveaxis(m_prev, 0, 2)

    causal = jnp.tril(jnp.ones((L, L), dtype=bool))
    log_d = jnp.where(causal, b[..., :, None] - b[..., None, :] + ig[..., None, :], -jnp.inf)
    log_inter = b + m_prev[..., None]
    m_t = jnp.maximum(log_d.max(-1), log_inter)
    p = jnp.exp(log_d - m_t[..., None]) * jnp.einsum('bhcld,bhcsd->bhcls', q, k)
    inter = jnp.exp(log_inter - m_t)
    num = (jnp.einsum('bhcls,bhcse->bhcle', p, v)
           + inter[..., None] * jnp.einsum('bhcld,bhcde->bhcle', q, C_prev))
    den = p.sum(-1) + inter * jnp.einsum('bhcld,bhcd->bhcl', q, n_prev)
    h = num / jnp.maximum(jnp.abs(den), jnp.exp(-m_t))[..., None]
    return jnp.moveaxis(h, 1, 3).reshape(B, S, H, dh)


def multiscale_pool(u):
    S = u.shape[1]
    pos = jnp.arange(1, S + 1, dtype=jnp.float32)[:, None]
    outs = []
    for g, w in enumerate(POOL_WINDOWS):
        ug = u[..., g * POOL_GROUP:(g + 1) * POOL_GROUP].astype(jnp.float32)
        cs = jnp.cumsum(ug, axis=1)
        lagged = jnp.pad(cs, ((0, 0), (w, 0), (0, 0)))[:, :S]
        outs.append((cs - lagged) / jnp.minimum(pos, w) - ug)
    return jnp.stack(outs, axis=2)


def hybrid_mixer(x, w_in, b_i, b_f, conv_qk, head_norm_g, pool_w, pool_scale, w_out):
    B, S, _ = x.shape
    M, H, dh = MLSTM_WIDTH, MLSTM_HEADS, MLSTM_HEAD_DIM
    z = x @ w_in
    qk = jax.nn.silu(causal_depthwise_conv(z[..., :2 * M], conv_qk))
    q = qk[..., :M].reshape(B, S, H, dh)
    k = qk[..., M:].reshape(B, S, H, dh)
    v = z[..., 2 * M:3 * M].reshape(B, S, H, dh)
    o_pre = z[..., 3 * M:4 * M]
    i_pre = z[..., 4 * M:4 * M + H] + b_i
    f_pre = z[..., 4 * M + H:4 * M + 2 * H] + b_f
    u = z[..., 4 * M + 2 * H:]

    h = mlstm_chunkwise(q, k, v, i_pre, f_pre)
    mu = h.mean(-1, keepdims=True)
    var = jnp.square(h - mu).mean(-1, keepdims=True)
    h = (h - mu) * lax.rsqrt(var + LN_EPS) * head_norm_g.reshape(H, dh).astype(jnp.float32)
    h = h.reshape(B, S, M) * jax.nn.sigmoid(o_pre.astype(jnp.float32))

    pooled = multiscale_pool(u)
    pm = jnp.einsum('bsgc,gcd->bsgd', pooled, pool_w.astype(jnp.float32))
    pm = pm.reshape(B, S, POOL_WIDTH) * pool_scale.astype(jnp.float32)

    mixed = jnp.concatenate([h, pm], axis=-1).astype(x.dtype)
    return mixed @ w_out


def memory_cross_attention(x, mem, w_q, w_kv, w_o):
    B, S, D = x.shape
    Mlen = mem.shape[1]
    q = (x @ w_q).reshape(B, S, XATTN_HEADS, XATTN_HEAD_DIM)
    kv = (mem @ w_kv).reshape(B, Mlen, 2, XATTN_HEADS, XATTN_HEAD_DIM)
    s = jnp.einsum('bshd,bmhd->bhsm', q, kv[:, :, 0]).astype(jnp.float32) * XATTN_HEAD_DIM ** -0.5
    p = jax.nn.softmax(s, axis=-1).astype(x.dtype)
    o = jnp.einsum('bhsm,bmhd->bshd', p, kv[:, :, 1]).reshape(B, S, D)
    return o @ w_o


def grouped_moe(x, router_w, router_bias, w_gate, w_up, w_down):
    B, S, D = x.shape
    T = B * S
    A = T * TOP_K
    xt = x.reshape(T, D)
    scores = jax.nn.sigmoid((xt @ router_w).astype(jnp.float32))
    sel = scores + router_bias.astype(jnp.float32)
    grp_score = lax.top_k(sel.reshape(T, N_GROUPS, EXPERTS_PER_GROUP), 2)[0].sum(-1)
    best = jnp.argmax(grp_score, axis=-1)
    in_grp = (jnp.arange(N_EXPERTS) // EXPERTS_PER_GROUP)[None, :] == best[:, None]
    _, idx = lax.top_k(jnp.where(in_grp, sel, -jnp.inf), TOP_K)
    gate = jnp.take_along_axis(scores, idx, axis=-1)
    gate = gate / gate.sum(-1, keepdims=True)

    e = idx.reshape(A).astype(jnp.int32)
    e_sorted, order = lax.sort((e, jnp.arange(A, dtype=jnp.int32)), num_keys=1)
    counts = jnp.bincount(e, length=N_EXPERTS)
    padded = (counts + MOE_BLOCK - 1) // MOE_BLOCK * MOE_BLOCK
    pend = jnp.cumsum(padded)
    pstart = pend - padded
    start = jnp.cumsum(counts) - counts
    dest_sorted = pstart[e_sorted] + jnp.arange(A, dtype=jnp.int32) - start[e_sorted]
    R = A + N_EXPERTS * MOE_BLOCK
    NB = R // MOE_BLOCK
    buf = jnp.zeros((R, D), x.dtype).at[dest_sorted].set(xt[order // TOP_K])
    blk_e = jnp.minimum(jnp.searchsorted(pend, jnp.arange(NB, dtype=jnp.int32) * MOE_BLOCK,
                                         side='right'), N_EXPERTS - 1)

    def expert_block(args):
        xb, ei = args
        hb = jax.nn.silu(xb @ w_gate[ei]) * (xb @ w_up[ei])
        return hb @ w_down[ei]

    yb = lax.map(expert_block, (buf.reshape(NB, MOE_BLOCK, D), blk_e)).reshape(R, D)
    dest = jnp.zeros((A,), jnp.int32).at[order].set(dest_sorted)
    y = (yb[dest].reshape(T, TOP_K, D) * gate[..., None].astype(x.dtype)).sum(1)
    return y.reshape(B, S, D)


def setup_inputs(seed: int = 0) -> dict:
    key = jax.random.key(seed)
    ks = jax.random.split(key, 24)
    f32 = jnp.float32
    D, L_ = D_MODEL, DEPTH
    beta = DEEPNORM_BETA
    nrm = lambda k, shape, s: jax.random.normal(k, shape, f32) * s
    col_scale = jnp.asarray(np.concatenate([
        np.ones(2 * MLSTM_WIDTH), np.full(MLSTM_WIDTH, beta), np.ones(MLSTM_WIDTH + 2 * MLSTM_HEADS),
        np.full(POOL_WIDTH, beta)]).astype(np.float32))
    kv_scale = jnp.asarray(np.concatenate([np.ones(D), np.full(D, beta)]).astype(np.float32))
    return {
        "x": nrm(ks[0], (BATCH, SEQ, D), 1.0),
        "mem": nrm(ks[1], (BATCH, MEM_LEN, D), 1.0),
        "w_in": nrm(ks[2], (L_, D, N_IN), D ** -0.5) * col_scale,
        "b_i": nrm(ks[3], (L_, MLSTM_HEADS), 0.1),
        "b_f": jnp.linspace(3.0, 6.0, MLSTM_HEADS, dtype=f32)[None, :] + nrm(ks[4], (L_, MLSTM_HEADS), 0.1),
        "conv_qk": nrm(ks[5], (L_, CONV_WIDTH, 2 * MLSTM_WIDTH), CONV_WIDTH ** -0.5),
        "head_norm_g": 1.0 + nrm(ks[6], (L_, MLSTM_WIDTH), 0.05),
        "pool_w": nrm(ks[7], (L_, len(POOL_WINDOWS), POOL_GROUP, POOL_GROUP), POOL_GROUP ** -0.5),
        "pool_scale": 1.0 + nrm(ks[8], (L_, POOL_WIDTH), 0.1),
        "w_mix_out": nrm(ks[9], (L_, MIX_WIDTH, D), MIX_WIDTH ** -0.5 * beta),
        "ln_mix_g": 1.0 + nrm(ks[10], (L_, D), 0.05),
        "ln_mix_b": nrm(ks[11], (L_, D), 0.02),
        "w_xq": nrm(ks[12], (L_, D, D), D ** -0.5),
        "w_xkv": nrm(ks[13], (L_, D, 2 * D), D ** -0.5) * kv_scale,
        "w_xo": nrm(ks[14], (L_, D, D), D ** -0.5 * beta),
        "ln_x_g": 1.0 + nrm(ks[15], (L_, D), 0.05),
        "ln_x_b": nrm(ks[16], (L_, D), 0.02),
        "router_w": nrm(ks[17], (D, N_EXPERTS), D ** -0.5),
        "router_bias": nrm(ks[18], (N_EXPERTS,), 0.01),
        "w_gate": nrm(ks[19], (L_, N_EXPERTS, D, D_EXPERT), D ** -0.5 * beta),
        "w_up": nrm(ks[20], (L_, N_EXPERTS, D, D_EXPERT), D ** -0.5 * beta),
        "w_down": nrm(ks[21], (L_, N_EXPERTS, D_EXPERT, D), D_EXPERT ** -0.5 * beta),
        "ln_moe_g": 1.0 + nrm(ks[22], (L_, D), 0.05),
        "ln_moe_b": nrm(ks[23], (L_, D), 0.02),
    }


def reference(x, mem, w_in, b_i, b_f, conv_qk, head_norm_g, pool_w, pool_scale, w_mix_out,
              ln_mix_g, ln_mix_b, w_xq, w_xkv, w_xo, ln_x_g, ln_x_b, router_w, router_bias,
              w_gate, w_up, w_down, ln_moe_g, ln_moe_b):
    for l in range(DEPTH):
        mix = hybrid_mixer(x, w_in[l], b_i[l], b_f[l], conv_qk[l], head_norm_g[l],
                           pool_w[l], pool_scale[l], w_mix_out[l])
        x = layer_norm(DEEPNORM_ALPHA * x + mix, ln_mix_g[l], ln_mix_b[l])
        xa = memory_cross_attention(x, mem, w_xq[l], w_xkv[l], w_xo[l])
        x = layer_norm(DEEPNORM_ALPHA * x + xa, ln_x_g[l], ln_x_b[l])
        ff = grouped_moe(x, router_w, router_bias, w_gate[l], w_up[l], w_down[l])
        x = layer_norm(DEEPNORM_ALPHA * x + ff, ln_moe_g[l], ln_moe_b[l])
    return x
```

```cpp
#include <hip/hip_runtime.h>
#include <cstdio>
#include <cstdint>
namespace slow {

constexpr int T = 32768, D = 1024, S = 2048, NB = 16, NIN = 2568;

__global__ void __launch_bounds__(256) sgemm_k(const float* __restrict__ A, int lda, const float* __restrict__ B, int ldb,
                                               float* __restrict__ C, int ldc, int M, int N, int K) {
    __shared__ float sA[16][64 + 4];
    __shared__ float sB[16][64 + 4];
    const int tid = threadIdx.x, tx = tid & 15, ty = tid >> 4;
    const int m0 = blockIdx.y * 64, n0 = blockIdx.x * 64;
    float acc[4][4];
#pragma unroll
    for (int i = 0; i < 4; ++i)
#pragma unroll
        for (int j = 0; j < 4; ++j) acc[i][j] = 0.f;
    for (int k0 = 0; k0 < K; k0 += 16) {
#pragma unroll
        for (int i = 0; i < 4; ++i) { const int e = tid + i * 256; const int r = e >> 4, c = e & 15; sA[c][r] = A[(size_t)(m0 + r) * lda + k0 + c]; }
#pragma unroll
        for (int i = 0; i < 4; ++i) { const int e = tid + i * 256; const int r = e >> 6, c = e & 63; sB[r][c] = (n0 + c < N) ? B[(size_t)(k0 + r) * ldb + n0 + c] : 0.f; }
        __syncthreads();
#pragma unroll
        for (int k = 0; k < 16; ++k) {
            float a[4], b[4];
#pragma unroll
            for (int i = 0; i < 4; ++i) a[i] = sA[k][ty * 4 + i];
#pragma unroll
            for (int j = 0; j < 4; ++j) b[j] = sB[k][tx * 4 + j];
#pragma unroll
            for (int i = 0; i < 4; ++i)
#pragma unroll
                for (int j = 0; j < 4; ++j) acc[i][j] = fmaf(a[i], b[j], acc[i][j]);
        }
        __syncthreads();
    }
#pragma unroll
    for (int i = 0; i < 4; ++i)
#pragma unroll
        for (int j = 0; j < 4; ++j) { const int n = n0 + tx * 4 + j; if (n < N) C[(size_t)(m0 + ty * 4 + i) * ldc + n] = acc[i][j]; }
}

__device__ __forceinline__ float sigmoidf_(float x) { return 1.f / (1.f + expf(-x)); }
__device__ __forceinline__ float siluf_(float x) { return x / (1.f + expf(-x)); }
__device__ __forceinline__ float logsigmoidf_(float x) { return fminf(x, 0.f) - log1pf(expf(-fabsf(x))); }

__global__ void gates_k(const float* __restrict__ Z, const float* __restrict__ b_i, const float* __restrict__ b_f, float* __restrict__ BC, float* __restrict__ IG) {
    const int id = blockIdx.x * blockDim.x + threadIdx.x; if (id >= NB * 4) return;
    const int b = id >> 2, h = id & 3; float c = 0.f;
    for (int t = 0; t < S; ++t) {
        const float* z = Z + (size_t)(b * S + t) * NIN;
        c += logsigmoidf_(z[2052 + h] + b_f[h]);
        BC[(size_t)id * S + t] = c; IG[(size_t)id * S + t] = z[2048 + h] + b_i[h];
    }
}
__global__ void conv_k(float* __restrict__ Z, const float* __restrict__ w  ) {
    const int id = blockIdx.x * blockDim.x + threadIdx.x; if (id >= NB * 1024) return;
    const int b = id >> 10, c = id & 1023;
    const float w0 = w[c], w1 = w[1024 + c], w2 = w[2048 + c], w3 = w[3072 + c];
    float* z = Z + (size_t)b * S * NIN + c;
    for (int t = S - 1; t >= 0; --t) {
        const float u3 = z[(size_t)t * NIN], u2 = t >= 1 ? z[(size_t)(t - 1) * NIN] : 0.f, u1 = t >= 2 ? z[(size_t)(t - 2) * NIN] : 0.f, u0 = t >= 3 ? z[(size_t)(t - 3) * NIN] : 0.f;
        z[(size_t)t * NIN] = siluf_(w0 * u0 + w1 * u1 + w2 * u2 + w3 * u3);
    }
}
__global__ void __launch_bounds__(128) mlstm_k(const float* __restrict__ Z, const float* __restrict__ BC, const float* __restrict__ IG,
                                               const float* __restrict__ hng  , float* __restrict__ MIXED) {
    const int t = blockIdx.x, h = blockIdx.y, b = blockIdx.z, j = threadIdx.x;
    __shared__ float sq[128]; __shared__ float sp[128]; __shared__ float red[4];
    const float* zb = Z + (size_t)b * S * NIN;
    sq[j] = zb[(size_t)t * NIN + h * 128 + j] * 0.08838834764831845f;
    const float* bc = BC + (size_t)(b * 4 + h) * S; const float* ig = IG + (size_t)(b * 4 + h) * S;
    const float Bt = bc[t];
    __syncthreads();
    float num = 0.f, den = 0.f;
    for (int s0 = 0; s0 <= t; s0 += 128) {
        const int s = s0 + j; float p = 0.f;
        if (s <= t) {
            const float4* kr = (const float4*)(zb + (size_t)s * NIN + 512 + h * 128); float dot = 0.f;
#pragma unroll 8
            for (int d = 0; d < 32; ++d) { const float4 kv = kr[d]; dot += sq[4 * d] * kv.x + sq[4 * d + 1] * kv.y + sq[4 * d + 2] * kv.z + sq[4 * d + 3] * kv.w; }
            p = expf(Bt - bc[s] + ig[s]) * dot;
        }
        sp[j] = p;
        __syncthreads();
        const int cnt = min(128, t - s0 + 1);
        for (int jj = 0; jj < cnt; ++jj) { const float pp = sp[jj]; num = fmaf(pp, zb[(size_t)(s0 + jj) * NIN + 1024 + h * 128 + j], num); den += pp; }
        __syncthreads();
    }
    float hv = num / fmaxf(fabsf(den), 1.f);
    float sum = hv;
#pragma unroll
    for (int o = 32; o > 0; o >>= 1) sum += __shfl_xor(sum, o);
    if ((j & 63) == 0) red[j >> 6] = sum;
    __syncthreads();
    const float mu = (red[0] + red[1]) * (1.f / 128.f);
    const float dv = hv - mu; float sq2 = dv * dv;
#pragma unroll
    for (int o = 32; o > 0; o >>= 1) sq2 += __shfl_xor(sq2, o);
    if ((j & 63) == 0) red[2 + (j >> 6)] = sq2;
    __syncthreads();
    const float var = (red[2] + red[3]) * (1.f / 128.f);
    const float hn = dv * rsqrtf(var + 1e-5f) * hng[h * 128 + j];
    const float og = sigmoidf_(zb[(size_t)t * NIN + 1536 + h * 128 + j]);
    MIXED[(size_t)(b * S + t) * 1024 + h * 128 + j] = hn * og;
}
__global__ void __launch_bounds__(512) pool_k(const float* __restrict__ Z, const float* __restrict__ pw  , const float* __restrict__ ps  , float* __restrict__ MIXED) {
    const int row = blockIdx.x, t = row & (S - 1), tid = threadIdx.x, g = tid >> 7, d = tid & 127;
    __shared__ float pl[512];
    const int w = 2 << g;
    float sum = 0.f;
    for (int r = 0; r < w; ++r) if (t - r >= 0) sum += Z[(size_t)(row - r) * NIN + 2056 + tid];
    pl[tid] = sum / (float)min(t + 1, w) - Z[(size_t)row * NIN + 2056 + tid];
    __syncthreads();
    float acc = 0.f;
    for (int c = 0; c < 128; ++c) acc = fmaf(pl[g * 128 + c], pw[(size_t)(g * 128 + c) * 128 + d], acc);
    MIXED[(size_t)row * 1024 + 512 + tid] = acc * ps[tid];
}
__global__ void __launch_bounds__(256) ln_k(float* __restrict__ X, const float* __restrict__ Y, const float* __restrict__ g, const float* __restrict__ bb) {
    const int row = blockIdx.x, tid = threadIdx.x; __shared__ float red[8];
    float4 x = ((const float4*)(X + (size_t)row * 1024))[tid]; const float4 y = ((const float4*)(Y + (size_t)row * 1024))[tid];
    const float al = 1.4142135623730951f;
    x.x = al * x.x + y.x; x.y = al * x.y + y.y; x.z = al * x.z + y.z; x.w = al * x.w + y.w;
    float s = (x.x + x.y) + (x.z + x.w);
#pragma unroll
    for (int o = 32; o > 0; o >>= 1) s += __shfl_xor(s, o);
    if ((tid & 63) == 0) red[tid >> 6] = s;
    __syncthreads();
    const float mu = (red[0] + red[1] + red[2] + red[3]) * (1.f / 1024.f);
    x.x -= mu; x.y -= mu; x.z -= mu; x.w -= mu;
    float q = (x.x * x.x + x.y * x.y) + (x.z * x.z + x.w * x.w);
#pragma unroll
    for (int o = 32; o > 0; o >>= 1) q += __shfl_xor(q, o);
    if ((tid & 63) == 0) red[4 + (tid >> 6)] = q;
    __syncthreads();
    const float rs = rsqrtf((red[4] + red[5] + red[6] + red[7]) * (1.f / 1024.f) + 1e-5f);
    const float4 gg = ((const float4*)g)[tid], b4 = ((const float4*)bb)[tid];
    float4 o; o.x = x.x * rs * gg.x + b4.x; o.y = x.y * rs * gg.y + b4.y; o.z = x.z * rs * gg.z + b4.z; o.w = x.w * rs * gg.w + b4.w;
    ((float4*)(X + (size_t)row * 1024))[tid] = o;
}
__global__ void __launch_bounds__(256) xattn_k(const float* __restrict__ Q, const float* __restrict__ KV, float* __restrict__ O) {
    const int row = blockIdx.x, h = blockIdx.y, b = row / S, tid = threadIdx.x;
    __shared__ float sq[256]; __shared__ float sp[256]; __shared__ float red[8];
    sq[tid] = Q[(size_t)row * 1024 + h * 256 + tid];
    __syncthreads();
    const float4* kr = (const float4*)(KV + (size_t)(b * 256 + tid) * 2048 + h * 256); float dot = 0.f;
#pragma unroll 8
    for (int d = 0; d < 64; ++d) { const float4 kv = kr[d]; dot += sq[4 * d] * kv.x + sq[4 * d + 1] * kv.y + sq[4 * d + 2] * kv.z + sq[4 * d + 3] * kv.w; }
    dot *= 0.0625f;
    float m = dot;
#pragma unroll
    for (int o = 32; o > 0; o >>= 1) m = fmaxf(m, __shfl_xor(m, o));
    if ((tid & 63) == 0) red[tid >> 6] = m;
    __syncthreads();
    m = fmaxf(fmaxf(red[0], red[1]), fmaxf(red[2], red[3]));
    const float e = expf(dot - m); float s = e;
#pragma unroll
    for (int o = 32; o > 0; o >>= 1) s += __shfl_xor(s, o);
    if ((tid & 63) == 0) red[4 + (tid >> 6)] = s;
    sp[tid] = e;
    __syncthreads();
    const float inv = 1.f / (red[4] + red[5] + red[6] + red[7]);
    float acc = 0.f;
    for (int mm = 0; mm < 256; ++mm) acc = fmaf(sp[mm], KV[(size_t)(b * 256 + mm) * 2048 + 1024 + h * 256 + tid], acc);
    O[(size_t)row * 1024 + h * 256 + tid] = acc * inv;
}
__global__ void __launch_bounds__(64) router_k(const float* __restrict__ X, const float* __restrict__ rw  , const float* __restrict__ rb, int* __restrict__ EI, float* __restrict__ GT) {
    const int row = blockIdx.x, lane = threadIdx.x;
    float acc[16];
#pragma unroll
    for (int e = 0; e < 16; ++e) acc[e] = 0.f;
    for (int i = 0; i < 16; ++i) { const int d = lane + 64 * i; const float xv = X[(size_t)row * 1024 + d]; const float4* r4 = (const float4*)(rw + (size_t)d * 16);
#pragma unroll
        for (int q = 0; q < 4; ++q) { const float4 r = r4[q]; acc[4 * q] = fmaf(xv, r.x, acc[4 * q]); acc[4 * q + 1] = fmaf(xv, r.y, acc[4 * q + 1]); acc[4 * q + 2] = fmaf(xv, r.z, acc[4 * q + 2]); acc[4 * q + 3] = fmaf(xv, r.w, acc[4 * q + 3]); } }
#pragma unroll
    for (int e = 0; e < 16; ++e) {
#pragma unroll
        for (int o = 32; o > 0; o >>= 1) acc[e] += __shfl_xor(acc[e], o);
    }
    if (lane == 0) {
        float sc[16], sel[16];
#pragma unroll
        for (int e = 0; e < 16; ++e) { sc[e] = sigmoidf_(acc[e]); sel[e] = sc[e] + rb[e]; }
        int best = 0; float bestv = -1e30f;
#pragma unroll
        for (int g = 0; g < 4; ++g) {
            float m1 = -1e30f, m2 = -1e30f;
#pragma unroll
            for (int i = 0; i < 4; ++i) { const float v = sel[4 * g + i]; if (v > m1) { m2 = m1; m1 = v; } else if (v > m2) m2 = v; }
            const float gs = m1 + m2; if (gs > bestv) { bestv = gs; best = g; }
        }
        int i1 = 0; float v1 = -1e30f;
#pragma unroll
        for (int i = 0; i < 4; ++i) { const float v = sel[4 * best + i]; if (v > v1) { v1 = v; i1 = i; } }
        int i2 = 0; float v2 = -1e30f;
#pragma unroll
        for (int i = 0; i < 4; ++i) { const float v = sel[4 * best + i]; if (i != i1 && v > v2) { v2 = v; i2 = i; } }
        const int e1 = 4 * best + i1, e2 = 4 * best + i2; const float g1 = sc[e1], g2 = sc[e2], inv = 1.f / (g1 + g2);
        EI[2 * row] = e1; EI[2 * row + 1] = e2; GT[2 * row] = g1 * inv; GT[2 * row + 1] = g2 * inv;
    }
}
__global__ void __launch_bounds__(256) moe_k(const float* __restrict__ X, const int* __restrict__ EI, const float* __restrict__ GT,
                                             const float* __restrict__ wg, const float* __restrict__ wu, const float* __restrict__ wd, float* __restrict__ FF) {
    const int row = blockIdx.x, tid = threadIdx.x; __shared__ float sx[1024]; __shared__ float sh[256];
    for (int i = tid; i < 1024; i += 256) sx[i] = X[(size_t)row * 1024 + i];
    float y[4] = {0.f, 0.f, 0.f, 0.f};
    __syncthreads();
    for (int k = 0; k < 2; ++k) {
        const int e = EI[2 * row + k]; const float gt = GT[2 * row + k];
        const float* g_ = wg + (size_t)e * 1024 * 256 + tid; const float* u_ = wu + (size_t)e * 1024 * 256 + tid;
        float ga = 0.f, ua = 0.f;
        for (int d = 0; d < 1024; ++d) { const float xv = sx[d]; ga = fmaf(xv, g_[(size_t)d * 256], ga); ua = fmaf(xv, u_[(size_t)d * 256], ua); }
        sh[tid] = siluf_(ga) * ua * gt;
        __syncthreads();
        const float* d_ = wd + (size_t)e * 256 * 1024 + tid;
        for (int j = 0; j < 256; ++j) { const float hv = sh[j];
#pragma unroll
            for (int c = 0; c < 4; ++c) y[c] = fmaf(hv, d_[(size_t)j * 1024 + c * 256], y[c]); }
        __syncthreads();
    }
#pragma unroll
    for (int c = 0; c < 4; ++c) FF[(size_t)row * 1024 + c * 256 + tid] = y[c];
}

struct Ws { float *Z, *MIXED, *R0, *R1, *KV, *BC, *IG, *GT; int* EI; };
inline Ws carve(void* d_ws) {
    char* w = (char*)d_ws; const size_t MiB = 1u << 20; Ws s;
    s.Z = (float*)w; s.R0 = (float*)w; s.R1 = (float*)(w + 128 * MiB);
    s.MIXED = (float*)(w + 336 * MiB);
    s.KV = (float*)(w + 465 * MiB); s.BC = (float*)(w + 497 * MiB); s.IG = (float*)(w + 498 * MiB);
    s.GT = (float*)(w + 499 * MiB); s.EI = (int*)(w + 500 * MiB);
    return s;
}
inline void sgemm(hipStream_t st, const float* A, int lda, const float* B, int ldb, float* C, int ldc, int M, int N, int K) {
    hipLaunchKernelGGL(sgemm_k, dim3((N + 63) / 64, M / 64), dim3(256), 0, st, A, lda, B, ldb, C, ldc, M, N, K);
}
inline void mixer(hipStream_t st, void* const* d_in, int l, float* X, const Ws& w) {
    const float* w_in = (const float*)d_in[2] + (size_t)l * D * NIN;
    sgemm(st, X, D, w_in, NIN, w.Z, NIN, T, NIN, D);
    hipLaunchKernelGGL(gates_k, dim3(1), dim3(64), 0, st, w.Z, (const float*)d_in[3] + l * 4, (const float*)d_in[4] + l * 4, w.BC, w.IG);
    hipLaunchKernelGGL(conv_k, dim3(NB * 1024 / 256), dim3(256), 0, st, w.Z, (const float*)d_in[5] + (size_t)l * 4096);
    hipLaunchKernelGGL(mlstm_k, dim3(S, 4, NB), dim3(128), 0, st, w.Z, w.BC, w.IG, (const float*)d_in[6] + l * 512, w.MIXED);
    hipLaunchKernelGGL(pool_k, dim3(T), dim3(512), 0, st, w.Z, (const float*)d_in[7] + (size_t)l * 65536, (const float*)d_in[8] + l * 512, w.MIXED);
    sgemm(st, w.MIXED, D, (const float*)d_in[9] + (size_t)l * D * D, D, w.R0, D, T, D, D);
    hipLaunchKernelGGL(ln_k, dim3(T), dim3(256), 0, st, X, w.R0, (const float*)d_in[10] + l * D, (const float*)d_in[11] + l * D);
}
inline void xattn(hipStream_t st, void* const* d_in, int l, float* X, const Ws& w) {
    sgemm(st, X, D, (const float*)d_in[12] + (size_t)l * D * D, D, w.R0, D, T, D, D);
    sgemm(st, (const float*)d_in[1], D, (const float*)d_in[13] + (size_t)l * D * 2 * D, 2 * D, w.KV, 2 * D, NB * 256, 2 * D, D);
    hipLaunchKernelGGL(xattn_k, dim3(T, 4), dim3(256), 0, st, w.R0, w.KV, w.R1);
    sgemm(st, w.R1, D, (const float*)d_in[14] + (size_t)l * D * D, D, w.R0, D, T, D, D);
    hipLaunchKernelGGL(ln_k, dim3(T), dim3(256), 0, st, X, w.R0, (const float*)d_in[15] + l * D, (const float*)d_in[16] + l * D);
}
inline void moe(hipStream_t st, void* const* d_in, int l, float* X, const Ws& w) {
    hipLaunchKernelGGL(router_k, dim3(T), dim3(64), 0, st, X, (const float*)d_in[17], (const float*)d_in[18], w.EI, w.GT);
    const size_t eo = (size_t)l * 16 * 1024 * 256;
    hipLaunchKernelGGL(moe_k, dim3(T), dim3(256), 0, st, X, w.EI, w.GT, (const float*)d_in[19] + eo, (const float*)d_in[20] + eo, (const float*)d_in[21] + eo, w.R0);
    hipLaunchKernelGGL(ln_k, dim3(T), dim3(256), 0, st, X, w.R0, (const float*)d_in[22] + l * D, (const float*)d_in[23] + l * D);
}
inline void forward(hipStream_t st, void* const* d_in, float* out, void* d_ws) {
    const Ws w = carve(d_ws);
    hipMemcpyAsync(out, d_in[0], (size_t)T * D * 4, hipMemcpyDeviceToDevice, st);
    for (int l = 0; l < 2; ++l) { mixer(st, d_in, l, out, w); xattn(st, d_in, l, out, w); moe(st, d_in, l, out, w); }
}
}
extern "C" void kernel_launch(void* const* d_in, const int* in_sizes, int n_in, void* d_out, int out_size, void* d_ws, size_t ws_size, hipStream_t stream) {
    if (n_in != 24 || out_size != slow::T * slow::D || ws_size < (size_t)501 * (1u << 20)) { fprintf(stderr, "kernel_launch: unexpected shapes n_in=%d out=%d ws=%zu\n", n_in, out_size, ws_size); return; }
    slow::forward(stream, d_in, (float*)d_out, d_ws);
}
```

```cpp
#include <hip/hip_runtime.h>
#include <cstdio>
#include <cstdint>
#define KMODE 1
namespace slow {

constexpr int T = 32768, D = 1024, S = 2048, NB = 16, NIN = 2568;

__global__ void __launch_bounds__(256) sgemm_k(const float* __restrict__ A, int lda, const float* __restrict__ B, int ldb,
                                               float* __restrict__ C, int ldc, int M, int N, int K) {
    __shared__ float sA[16][64 + 4];
    __shared__ float sB[16][64 + 4];
    const int tid = threadIdx.x, tx = tid & 15, ty = tid >> 4;
    const int m0 = blockIdx.y * 64, n0 = blockIdx.x * 64;
    float acc[4][4];
#pragma unroll
    for (int i = 0; i < 4; ++i)
#pragma unroll
        for (int j = 0; j < 4; ++j) acc[i][j] = 0.f;
    for (int k0 = 0; k0 < K; k0 += 16) {
#pragma unroll
        for (int i = 0; i < 4; ++i) { const int e = tid + i * 256; const int r = e >> 4, c = e & 15; sA[c][r] = A[(size_t)(m0 + r) * lda + k0 + c]; }
#pragma unroll
        for (int i = 0; i < 4; ++i) { const int e = tid + i * 256; const int r = e >> 6, c = e & 63; sB[r][c] = (n0 + c < N) ? B[(size_t)(k0 + r) * ldb + n0 + c] : 0.f; }
        __syncthreads();
#pragma unroll
        for (int k = 0; k < 16; ++k) {
            float a[4], b[4];
#pragma unroll
            for (int i = 0; i < 4; ++i) a[i] = sA[k][ty * 4 + i];
#pragma unroll
            for (int j = 0; j < 4; ++j) b[j] = sB[k][tx * 4 + j];
#pragma unroll
            for (int i = 0; i < 4; ++i)
#pragma unroll
                for (int j = 0; j < 4; ++j) acc[i][j] = fmaf(a[i], b[j], acc[i][j]);
        }
        __syncthreads();
    }
#pragma unroll
    for (int i = 0; i < 4; ++i)
#pragma unroll
        for (int j = 0; j < 4; ++j) { const int n = n0 + tx * 4 + j; if (n < N) C[(size_t)(m0 + ty * 4 + i) * ldc + n] = acc[i][j]; }
}

__device__ __forceinline__ float sigmoidf_(float x) { return 1.f / (1.f + expf(-x)); }
__device__ __forceinline__ float siluf_(float x) { return x / (1.f + expf(-x)); }
__device__ __forceinline__ float logsigmoidf_(float x) { return fminf(x, 0.f) - log1pf(expf(-fabsf(x))); }

__global__ void gates_k(const float* __restrict__ Z, const float* __restrict__ b_i, const float* __restrict__ b_f, float* __restrict__ BC, float* __restrict__ IG) {
    const int id = blockIdx.x * blockDim.x + threadIdx.x; if (id >= NB * 4) return;
    const int b = id >> 2, h = id & 3; float c = 0.f;
    for (int t = 0; t < S; ++t) {
        const float* z = Z + (size_t)(b * S + t) * NIN;
        c += logsigmoidf_(z[2052 + h] + b_f[h]);
        BC[(size_t)id * S + t] = c; IG[(size_t)id * S + t] = z[2048 + h] + b_i[h];
    }
}
__global__ void conv_k(float* __restrict__ Z, const float* __restrict__ w  ) {
    const int id = blockIdx.x * blockDim.x + threadIdx.x; if (id >= NB * 1024) return;
    const int b = id >> 10, c = id & 1023;
    const float w0 = w[c], w1 = w[1024 + c], w2 = w[2048 + c], w3 = w[3072 + c];
    float* z = Z + (size_t)b * S * NIN + c;
    for (int t = S - 1; t >= 0; --t) {
        const float u3 = z[(size_t)t * NIN], u2 = t >= 1 ? z[(size_t)(t - 1) * NIN] : 0.f, u1 = t >= 2 ? z[(size_t)(t - 2) * NIN] : 0.f, u0 = t >= 3 ? z[(size_t)(t - 3) * NIN] : 0.f;
        z[(size_t)t * NIN] = siluf_(w0 * u0 + w1 * u1 + w2 * u2 + w3 * u3);
    }
}
__global__ void __launch_bounds__(128) mlstm_k(const float* __restrict__ Z, const float* __restrict__ BC, const float* __restrict__ IG,
                                               const float* __restrict__ hng  , float* __restrict__ MIXED) {
    const int t = blockIdx.x, h = blockIdx.y, b = blockIdx.z, j = threadIdx.x;
    __shared__ float sq[128]; __shared__ float sp[128]; __shared__ float red[4];
    const float* zb = Z + (size_t)b * S * NIN;
    sq[j] = zb[(size_t)t * NIN + h * 128 + j] * 0.08838834764831845f;
    const float* bc = BC + (size_t)(b * 4 + h) * S; const float* ig = IG + (size_t)(b * 4 + h) * S;
    const float Bt = bc[t];
    __syncthreads();
    float num = 0.f, den = 0.f;
    for (int s0 = 0; s0 <= t; s0 += 128) {
        const int s = s0 + j; float p = 0.f;
        if (s <= t) {
            const float4* kr = (const float4*)(zb + (size_t)s * NIN + 512 + h * 128); float dot = 0.f;
#pragma unroll 8
            for (int d = 0; d < 32; ++d) { const float4 kv = kr[d]; dot += sq[4 * d] * kv.x + sq[4 * d + 1] * kv.y + sq[4 * d + 2] * kv.z + sq[4 * d + 3] * kv.w; }
            p = expf(Bt - bc[s] + ig[s]) * dot;
        }
        sp[j] = p;
        __syncthreads();
        const int cnt = min(128, t - s0 + 1);
        for (int jj = 0; jj < cnt; ++jj) { const float pp = sp[jj]; num = fmaf(pp, zb[(size_t)(s0 + jj) * NIN + 1024 + h * 128 + j], num); den += pp; }
        __syncthreads();
    }
    float hv = num / fmaxf(fabsf(den), 1.f);
    float sum = hv;
#pragma unroll
    for (int o = 32; o > 0; o >>= 1) sum += __shfl_xor(sum, o);
    if ((j & 63) == 0) red[j >> 6] = sum;
    __syncthreads();
    const float mu = (red[0] + red[1]) * (1.f / 128.f);
    const float dv = hv - mu; float sq2 = dv * dv;
#pragma unroll
    for (int o = 32; o > 0; o >>= 1) sq2 += __shfl_xor(sq2, o);
    if ((j & 63) == 0) red[2 + (j >> 6)] = sq2;
    __syncthreads();
    const float var = (red[2] + red[3]) * (1.f / 128.f);
    const float hn = dv * rsqrtf(var + 1e-5f) * hng[h * 128 + j];
    const float og = sigmoidf_(zb[(size_t)t * NIN + 1536 + h * 128 + j]);
    MIXED[(size_t)(b * S + t) * 1024 + h * 128 + j] = hn * og;
}
__global__ void __launch_bounds__(512) pool_k(const float* __restrict__ Z, const float* __restrict__ pw  , const float* __restrict__ ps  , float* __restrict__ MIXED) {
    const int row = blockIdx.x, t = row & (S - 1), tid = threadIdx.x, g = tid >> 7, d = tid & 127;
    __shared__ float pl[512];
    const int w = 2 << g;
    float sum = 0.f;
    for (int r = 0; r < w; ++r) if (t - r >= 0) sum += Z[(size_t)(row - r) * NIN + 2056 + tid];
    pl[tid] = sum / (float)min(t + 1, w) - Z[(size_t)row * NIN + 2056 + tid];
    __syncthreads();
    float acc = 0.f;
    for (int c = 0; c < 128; ++c) acc = fmaf(pl[g * 128 + c], pw[(size_t)(g * 128 + c) * 128 + d], acc);
    MIXED[(size_t)row * 1024 + 512 + tid] = acc * ps[tid];
}
__global__ void __launch_bounds__(256) ln_k(float* __restrict__ X, const float* __restrict__ Y, const float* __restrict__ g, const float* __restrict__ bb) {
    const int row = blockIdx.x, tid = threadIdx.x; __shared__ float red[8];
    float4 x = ((const float4*)(X + (size_t)row * 1024))[tid]; const float4 y = ((const float4*)(Y + (size_t)row * 1024))[tid];
    const float al = 1.4142135623730951f;
    x.x = al * x.x + y.x; x.y = al * x.y + y.y; x.z = al * x.z + y.z; x.w = al * x.w + y.w;
    float s = (x.x + x.y) + (x.z + x.w);
#pragma unroll
    for (int o = 32; o > 0; o >>= 1) s += __shfl_xor(s, o);
    if ((tid & 63) == 0) red[tid >> 6] = s;
    __syncthreads();
    const float mu = (red[0] + red[1] + red[2] + red[3]) * (1.f / 1024.f);
    x.x -= mu; x.y -= mu; x.z -= mu; x.w -= mu;
    float q = (x.x * x.x + x.y * x.y) + (x.z * x.z + x.w * x.w);
#pragma unroll
    for (int o = 32; o > 0; o >>= 1) q += __shfl_xor(q, o);
    if ((tid & 63) == 0) red[4 + (tid >> 6)] = q;
    __syncthreads();
    const float rs = rsqrtf((red[4] + red[5] + red[6] + red[7]) * (1.f / 1024.f) + 1e-5f);
    const float4 gg = ((const float4*)g)[tid], b4 = ((const float4*)bb)[tid];
    float4 o; o.x = x.x * rs * gg.x + b4.x; o.y = x.y * rs * gg.y + b4.y; o.z = x.z * rs * gg.z + b4.z; o.w = x.w * rs * gg.w + b4.w;
    ((float4*)(X + (size_t)row * 1024))[tid] = o;
}
__global__ void __launch_bounds__(256) xattn_k(const float* __restrict__ Q, const float* __restrict__ KV, float* __restrict__ O) {
    const int row = blockIdx.x, h = blockIdx.y, b = row / S, tid = threadIdx.x;
    __shared__ float sq[256]; __shared__ float sp[256]; __shared__ float red[8];
    sq[tid] = Q[(size_t)row * 1024 + h * 256 + tid];
    __syncthreads();
    const float4* kr = (const float4*)(KV + (size_t)(b * 256 + tid) * 2048 + h * 256); float dot = 0.f;
#pragma unroll 8
    for (int d = 0; d < 64; ++d) { const float4 kv = kr[d]; dot += sq[4 * d] * kv.x + sq[4 * d + 1] * kv.y + sq[4 * d + 2] * kv.z + sq[4 * d + 3] * kv.w; }
    dot *= 0.0625f;
    float m = dot;
#pragma unroll
    for (int o = 32; o > 0; o >>= 1) m = fmaxf(m, __shfl_xor(m, o));
    if ((tid & 63) == 0) red[tid >> 6] = m;
    __syncthreads();
    m = fmaxf(fmaxf(red[0], red[1]), fmaxf(red[2], red[3]));
    const float e = expf(dot - m); float s = e;
#pragma unroll
    for (int o = 32; o > 0; o >>= 1) s += __shfl_xor(s, o);
    if ((tid & 63) == 0) red[4 + (tid >> 6)] = s;
    sp[tid] = e;
    __syncthreads();
    const float inv = 1.f / (red[4] + red[5] + red[6] + red[7]);
    float acc = 0.f;
    for (int mm = 0; mm < 256; ++mm) acc = fmaf(sp[mm], KV[(size_t)(b * 256 + mm) * 2048 + 1024 + h * 256 + tid], acc);
    O[(size_t)row * 1024 + h * 256 + tid] = acc * inv;
}
__global__ void __launch_bounds__(64) router_k(const float* __restrict__ X, const float* __restrict__ rw  , const float* __restrict__ rb, int* __restrict__ EI, float* __restrict__ GT) {
    const int row = blockIdx.x, lane = threadIdx.x;
    float acc[16];
#pragma unroll
    for (int e = 0; e < 16; ++e) acc[e] = 0.f;
    for (int i = 0; i < 16; ++i) { const int d = lane + 64 * i; const float xv = X[(size_t)row * 1024 + d]; const float4* r4 = (const float4*)(rw + (size_t)d * 16);
#pragma unroll
        for (int q = 0; q < 4; ++q) { const float4 r = r4[q]; acc[4 * q] = fmaf(xv, r.x, acc[4 * q]); acc[4 * q + 1] = fmaf(xv, r.y, acc[4 * q + 1]); acc[4 * q + 2] = fmaf(xv, r.z, acc[4 * q + 2]); acc[4 * q + 3] = fmaf(xv, r.w, acc[4 * q + 3]); } }
#pragma unroll
    for (int e = 0; e < 16; ++e) {
#pragma unroll
        for (int o = 32; o > 0; o >>= 1) acc[e] += __shfl_xor(acc[e], o);
    }
    if (lane == 0) {
        float sc[16], sel[16];
#pragma unroll
        for (int e = 0; e < 16; ++e) { sc[e] = sigmoidf_(acc[e]); sel[e] = sc[e] + rb[e]; }
        int best = 0; float bestv = -1e30f;
#pragma unroll
        for (int g = 0; g < 4; ++g) {
            float m1 = -1e30f, m2 = -1e30f;
#pragma unroll
            for (int i = 0; i < 4; ++i) { const float v = sel[4 * g + i]; if (v > m1) { m2 = m1; m1 = v; } else if (v > m2) m2 = v; }
            const float gs = m1 + m2; if (gs > bestv) { bestv = gs; best = g; }
        }
        int i1 = 0; float v1 = -1e30f;
#pragma unroll
        for (int i = 0; i < 4; ++i) { const float v = sel[4 * best + i]; if (v > v1) { v1 = v; i1 = i; } }
        int i2 = 0; float v2 = -1e30f;
#pragma unroll
        for (int i = 0; i < 4; ++i) { const float v = sel[4 * best + i]; if (i != i1 && v > v2) { v2 = v; i2 = i; } }
        const int e1 = 4 * best + i1, e2 = 4 * best + i2; const float g1 = sc[e1], g2 = sc[e2], inv = 1.f / (g1 + g2);
        EI[2 * row] = e1; EI[2 * row + 1] = e2; GT[2 * row] = g1 * inv; GT[2 * row + 1] = g2 * inv;
    }
}
__global__ void __launch_bounds__(256) moe_k(const float* __restrict__ X, const int* __restrict__ EI, const float* __restrict__ GT,
                                             const float* __restrict__ wg, const float* __restrict__ wu, const float* __restrict__ wd, float* __restrict__ FF) {
    const int row = blockIdx.x, tid = threadIdx.x; __shared__ float sx[1024]; __shared__ float sh[256];
    for (int i = tid; i < 1024; i += 256) sx[i] = X[(size_t)row * 1024 + i];
    float y[4] = {0.f, 0.f, 0.f, 0.f};
    __syncthreads();
    for (int k = 0; k < 2; ++k) {
        const int e = EI[2 * row + k]; const float gt = GT[2 * row + k];
        const float* g_ = wg + (size_t)e * 1024 * 256 + tid; const float* u_ = wu + (size_t)e * 1024 * 256 + tid;
        float ga = 0.f, ua = 0.f;
        for (int d = 0; d < 1024; ++d) { const float xv = sx[d]; ga = fmaf(xv, g_[(size_t)d * 256], ga); ua = fmaf(xv, u_[(size_t)d * 256], ua); }
        sh[tid] = siluf_(ga) * ua * gt;
        __syncthreads();
        const float* d_ = wd + (size_t)e * 256 * 1024 + tid;
        for (int j = 0; j < 256; ++j) { const float hv = sh[j];
#pragma unroll
            for (int c = 0; c < 4; ++c) y[c] = fmaf(hv, d_[(size_t)j * 1024 + c * 256], y[c]); }
        __syncthreads();
    }
#pragma unroll
    for (int c = 0; c < 4; ++c) FF[(size_t)row * 1024 + c * 256 + tid] = y[c];
}

struct Ws { float *Z, *MIXED, *R0, *R1, *KV, *BC, *IG, *GT; int* EI; };
inline Ws carve(void* d_ws) {
    char* w = (char*)d_ws; const size_t MiB = 1u << 20; Ws s;
    s.Z = (float*)w; s.R0 = (float*)w; s.R1 = (float*)(w + 128 * MiB);
    s.MIXED = (float*)(w + 336 * MiB);
    s.KV = (float*)(w + 465 * MiB); s.BC = (float*)(w + 497 * MiB); s.IG = (float*)(w + 498 * MiB);
    s.GT = (float*)(w + 499 * MiB); s.EI = (int*)(w + 500 * MiB);
    return s;
}
inline void sgemm(hipStream_t st, const float* A, int lda, const float* B, int ldb, float* C, int ldc, int M, int N, int K) {
    hipLaunchKernelGGL(sgemm_k, dim3((N + 63) / 64, M / 64), dim3(256), 0, st, A, lda, B, ldb, C, ldc, M, N, K);
}
inline void mixer(hipStream_t st, void* const* d_in, int l, float* X, const Ws& w) {
    const float* w_in = (const float*)d_in[2] + (size_t)l * D * NIN;
    sgemm(st, X, D, w_in, NIN, w.Z, NIN, T, NIN, D);
    hipLaunchKernelGGL(gates_k, dim3(1), dim3(64), 0, st, w.Z, (const float*)d_in[3] + l * 4, (const float*)d_in[4] + l * 4, w.BC, w.IG);
    hipLaunchKernelGGL(conv_k, dim3(NB * 1024 / 256), dim3(256), 0, st, w.Z, (const float*)d_in[5] + (size_t)l * 4096);
    hipLaunchKernelGGL(mlstm_k, dim3(S, 4, NB), dim3(128), 0, st, w.Z, w.BC, w.IG, (const float*)d_in[6] + l * 512, w.MIXED);
    hipLaunchKernelGGL(pool_k, dim3(T), dim3(512), 0, st, w.Z, (const float*)d_in[7] + (size_t)l * 65536, (const float*)d_in[8] + l * 512, w.MIXED);
    sgemm(st, w.MIXED, D, (const float*)d_in[9] + (size_t)l * D * D, D, w.R0, D, T, D, D);
    hipLaunchKernelGGL(ln_k, dim3(T), dim3(256), 0, st, X, w.R0, (const float*)d_in[10] + l * D, (const float*)d_in[11] + l * D);
}
inline void xattn(hipStream_t st, void* const* d_in, int l, float* X, const Ws& w) {
    sgemm(st, X, D, (const float*)d_in[12] + (size_t)l * D * D, D, w.R0, D, T, D, D);
    sgemm(st, (const float*)d_in[1], D, (const float*)d_in[13] + (size_t)l * D * 2 * D, 2 * D, w.KV, 2 * D, NB * 256, 2 * D, D);
    hipLaunchKernelGGL(xattn_k, dim3(T, 4), dim3(256), 0, st, w.R0, w.KV, w.R1);
    sgemm(st, w.R1, D, (const float*)d_in[14] + (size_t)l * D * D, D, w.R0, D, T, D, D);
    hipLaunchKernelGGL(ln_k, dim3(T), dim3(256), 0, st, X, w.R0, (const float*)d_in[15] + l * D, (const float*)d_in[16] + l * D);
}
inline void moe(hipStream_t st, void* const* d_in, int l, float* X, const Ws& w) {
    hipLaunchKernelGGL(router_k, dim3(T), dim3(64), 0, st, X, (const float*)d_in[17], (const float*)d_in[18], w.EI, w.GT);
    const size_t eo = (size_t)l * 16 * 1024 * 256;
    hipLaunchKernelGGL(moe_k, dim3(T), dim3(256), 0, st, X, w.EI, w.GT, (const float*)d_in[19] + eo, (const float*)d_in[20] + eo, (const float*)d_in[21] + eo, w.R0);
    hipLaunchKernelGGL(ln_k, dim3(T), dim3(256), 0, st, X, w.R0, (const float*)d_in[22] + l * D, (const float*)d_in[23] + l * D);
}
inline void forward(hipStream_t st, void* const* d_in, float* out, void* d_ws) {
    const Ws w = carve(d_ws);
    hipMemcpyAsync(out, d_in[0], (size_t)T * D * 4, hipMemcpyDeviceToDevice, st);
    for (int l = 0; l < 2; ++l) { mixer(st, d_in, l, out, w); xattn(st, d_in, l, out, w); moe(st, d_in, l, out, w); }
}
}
#define GAS __attribute__((address_space(1)))
#define LAS __attribute__((address_space(3)))
typedef unsigned short bf16;
typedef short bf16x8 __attribute__((ext_vector_type(8)));
typedef float f32x4 __attribute__((ext_vector_type(4)));
typedef float f32x2 __attribute__((ext_vector_type(2)));
typedef unsigned u32x4 __attribute__((ext_vector_type(4)));
typedef unsigned u32x2 __attribute__((ext_vector_type(2)));
#define RLX_AGENT __ATOMIC_RELAXED, __HIP_MEMORY_SCOPE_AGENT
#define LDS_WAIT() asm volatile("s_waitcnt lgkmcnt(0)" ::: "memory")
#define VM_WAIT() asm volatile("s_waitcnt vmcnt(0)" ::: "memory")

__device__ __forceinline__ unsigned f2bf(float f) { unsigned u = __builtin_bit_cast(unsigned, f); return (u + 0x7fffu + ((u >> 16) & 1u)) >> 16; }
__device__ __forceinline__ unsigned pk2(float lo, float hi) { unsigned r; asm volatile("v_cvt_pk_bf16_f32 %0, %1, %2" : "=v"(r) : "v"(lo), "v"(hi)); return r; }
__device__ __forceinline__ float bf2f(unsigned short h) { return __builtin_bit_cast(float, (unsigned)h << 16); }
__device__ __forceinline__ float bflo(unsigned w) { return __builtin_bit_cast(float, w << 16); }
__device__ __forceinline__ float bfhi(unsigned w) { return __builtin_bit_cast(float, w & 0xffff0000u); }
__device__ __forceinline__ float sigm(float x) { return 1.f / (1.f + __expf(-x)); }
__device__ __forceinline__ float silu(float x) { return x / (1.f + __expf(-x)); }
__device__ __forceinline__ float logsig(float x) { return fminf(x, 0.f) - log1pf(__expf(-fabsf(x))); }
__device__ __forceinline__ float wave_sum(float v) {
#pragma unroll
    for (int o = 1; o < 64; o <<= 1) v += __shfl_xor(v, o);
    return v;
}
__device__ __forceinline__ float wave_max(float v) {
#pragma unroll
    for (int o = 1; o < 64; o <<= 1) v = fmaxf(v, __shfl_xor(v, o));
    return v;
}

#define XB_TMO      128
#define XB_XCNT(j)  (256  + 64 * (j))
#define XB_XSUB(j)  (1280 + 64 * (j))
#define XB_XGEN(j)  (2304 + 64 * (j))
#define XB_TOP      3328
#define XB_TOPGEN   3392
#define XCD_BAR_WORDS 3456
#define XB_SPIN_CAP (1u << 18)
__device__ __forceinline__ unsigned xb_ld(unsigned* p)              { return __hip_atomic_load(p, __ATOMIC_RELAXED, __HIP_MEMORY_SCOPE_AGENT); }
__device__ __forceinline__ unsigned xb_add(unsigned* p, unsigned v) { return __hip_atomic_fetch_add(p, v, __ATOMIC_RELAXED, __HIP_MEMORY_SCOPE_AGENT); }
__device__ __forceinline__ unsigned xb_xcc_id() { return (unsigned)__builtin_amdgcn_s_getreg((3 << 11) | 20) & 0xFu; }
#define XB_SPIN(cond, bar) do { unsigned _sp = 0; while (cond) { __builtin_amdgcn_s_sleep(1); \
    if ((++_sp & 255u) == 0u) { if (xb_ld(&(bar)[XB_TMO])) break; if (_sp > XB_SPIN_CAP) { atomicAdd(&(bar)[XB_TMO], 1u); break; } } } } while (0)
struct XcdBarrier { unsigned* bar; unsigned x; volatile LAS unsigned* st; };
__device__ __forceinline__ XcdBarrier xcd_barrier_post(unsigned* bar, volatile LAS unsigned* st) {
    XcdBarrier b; b.bar = bar; b.x = xb_xcc_id(); b.st = st;
    if (threadIdx.x == 0) (void)xb_add(&bar[XB_XCNT(b.x)], 1u);
    return b;
}
__device__ __forceinline__ void xcd_barrier_complete(unsigned* bar, unsigned x, unsigned& nloc, unsigned& nx) {
    const unsigned G = gridDim.x * gridDim.y * gridDim.z;
    unsigned sum, cnt, mine, sp = 0u;
    for (;;) {
        sum = 0u; cnt = 0u; mine = 0u;
#pragma unroll
        for (unsigned j = 0; j < 16; ++j) { const unsigned c = xb_ld(&bar[XB_XCNT(j)]); sum += c; cnt += (c > 0u) ? 1u : 0u; mine = (j == x) ? c : mine; }
        if (sum == G) break;
        __builtin_amdgcn_s_sleep(1);
        if ((++sp & 255u) == 0u) { if (xb_ld(&bar[XB_TMO])) break; if (sp > XB_SPIN_CAP) { atomicAdd(&bar[XB_TMO], 1u); break; } }
    }
    nloc = mine > 0u ? mine : 1u; nx = cnt > 0u ? cnt : 1u;
}
__device__ __forceinline__ void xcd_barrier(const XcdBarrier& b) {
    asm volatile("s_waitcnt vmcnt(0)" ::: "memory");
    __syncthreads();
    if (threadIdx.x == 0) {
        unsigned* bar = b.bar;
        __builtin_amdgcn_s_waitcnt(0);
        unsigned nloc = b.st[0], nx = b.st[1];
        if (nloc == 0u) { xcd_barrier_complete(bar, b.x, nloc, nx); b.st[0] = nloc; b.st[1] = nx; }
        const unsigned old = xb_add(&bar[XB_XSUB(b.x)], 1u);
        const unsigned gen = old / nloc;
        if (old + 1u == (gen + 1u) * nloc) {
            __builtin_amdgcn_fence(__ATOMIC_RELEASE, "agent");
            asm volatile("s_waitcnt vmcnt(0)" ::: "memory");
            const unsigned og = xb_add(&bar[XB_TOP], 1u);
            const unsigned tg = og / nx;
            if (og + 1u == (tg + 1u) * nx) xb_add(&bar[XB_TOPGEN], 1u);
            else XB_SPIN(xb_ld(&bar[XB_TOPGEN]) == tg, bar);
            __builtin_amdgcn_fence(__ATOMIC_ACQUIRE, "agent");
            xb_add(&bar[XB_XGEN(b.x)], 1u);
            asm volatile("s_waitcnt vmcnt(0)" ::: "memory");
        } else {
            XB_SPIN(xb_ld(&bar[XB_XGEN(b.x)]) == gen, bar);
            __builtin_amdgcn_fence(__ATOMIC_ACQUIRE, "agent");
            asm volatile("s_waitcnt vmcnt(0)" ::: "memory");
        }
    }
    __syncthreads();
}

namespace pg8 {
constexpr int BM = 256, BK = 64, HALF = 128, HTB = HALF * BK * 2, STAGE_BYTES = 8 * HTB;
__host__ __device__ __forceinline__ int lds_byte(int r, int c) { const int st = (r >> 4) * 2 + (c >> 5), rr = r & 15, cc = c & 31, ob = rr * 64 + cc * 2; return st * 1024 + (ob ^ (((ob >> 9) & 1) << 5)); }
__host__ __device__ __forceinline__ void stage_rc(int b, int& R, int& C) { const int st = b / 1024, sb = b % 1024, swz = sb ^ (((sb >> 9) & 1) << 5); R = (st >> 1) * 16 + swz / 64; C = (st & 1) * 32 + (swz % 64) / 2; }
__host__ __device__ __forceinline__ int perm32(int rho) { const int n = rho >> 4, i = rho & 15; return 8 * (i >> 2) + 4 * n + (i & 3); }

struct Unit { const char* a; const char* b; void* o; int aux, aux2; };
struct Gemm { int lda, ldb, K; };

template <class Epi, class Sched>
__device__ __forceinline__ void gemm_phase(LAS unsigned char* lds, const Gemm g, const Sched& S, const Epi& E) {
    int tid_ = threadIdx.x; asm volatile("" : "+v"(tid_));
    const int tid = tid_, wid = __builtin_amdgcn_readfirstlane(tid >> 6), lane = tid & 63, wr = wid >> 2, wc = wid & 3, fr = lane & 15, fq = lane >> 4;
    const int K = g.K, nt = K / BK;
    unsigned voffA[2], voffB[2];
#pragma unroll
    for (int i = 0; i < 2; ++i) { int R, C; stage_rc(tid * 16 + i * 8192, R, C); const int Rb = Epi::PERM ? ((R & ~31) + perm32(R & 31)) : R;
        voffA[i] = (unsigned)(R * g.lda + C) * 2u; voffB[i] = (unsigned)(Rb * g.ldb + C) * 2u; }
    const size_t kstep = (size_t)(BK * 2);
    const size_t hstepA = (size_t)HALF * g.lda * 2, hstepB = (size_t)HALF * g.ldb * 2;
    const unsigned ldsw = (unsigned)wid * 1024u;
    const int aoff = lds_byte(wr * 64 + fr, fq * 8), boff = lds_byte(wc * 32 + fr, fq * 8);
#define PG8_SA(b, h) (((b) * 2 + (h)) * HTB)
#define PG8_SB(b, h) ((4 + (b) * 2 + (h)) * HTB)
#define PG8_STAGE(bufoff, gbase, voff) do { _Pragma("unroll") for (int _i = 0; _i < 2; ++_i) \
        __builtin_amdgcn_global_load_lds((const unsigned*)((const char*)(gbase) + (voff)[_i]), (LAS unsigned*)(lds + (bufoff) + ldsw + _i * 8192), 16, 0, 0); } while (0)
#define PG8_LDA(dst, b, h) do { _Pragma("unroll") for (int m = 0; m < 4; ++m) _Pragma("unroll") for (int k = 0; k < 2; ++k) dst[m][k] = *(const LAS bf16x8*)(lds + PG8_SA(b, h) + aoff + m * 2048 + k * 1024); } while (0)
#define PG8_LDB(dst, b, h) do { _Pragma("unroll") for (int n = 0; n < 2; ++n) _Pragma("unroll") for (int k = 0; k < 2; ++k) dst[n][k] = *(const LAS bf16x8*)(lds + PG8_SB(b, h) + boff + n * 2048 + k * 1024); } while (0)
#define PG8_MMA(ai, bj, At, Bt) do { __builtin_amdgcn_s_setprio(1); _Pragma("unroll") for (int m = 0; m < 4; ++m) _Pragma("unroll") for (int n = 0; n < 2; ++n) _Pragma("unroll") for (int k = 0; k < 2; ++k) \
        acc[ai][bj][m][n] = __builtin_amdgcn_mfma_f32_16x16x32_bf16(Bt[n][k], At[m][k], acc[ai][bj][m][n], 0, 0, 0); __builtin_amdgcn_s_setprio(0); } while (0)
#define PG8_WAIT_V(n) asm volatile("s_waitcnt vmcnt(" #n ")" ::: "memory")
#define PG8_WAIT_L(n) asm volatile("s_waitcnt lgkmcnt(" #n ")" ::: "memory")
#define PG8_BAR __builtin_amdgcn_s_barrier()
#define PG8_SCHED __builtin_amdgcn_sched_barrier(0)
    Unit cur, nxt; int ui = 0;
    if (!S.next(0, cur)) return;
    f32x4 acc[2][2][4][2];
#pragma unroll
    for (int a = 0; a < 2; ++a)
#pragma unroll
        for (int b = 0; b < 2; ++b)
#pragma unroll
            for (int m = 0; m < 4; ++m)
#pragma unroll
                for (int n = 0; n < 2; ++n) acc[a][b][m][n] = (f32x4){0.f, 0.f, 0.f, 0.f};
    bf16x8 At[4][2], B0[2][2], B1[2][2];
    const char* cA = cur.a; const char* cB = cur.b;
    PG8_STAGE(PG8_SB(0, 0), cB, voffB); PG8_STAGE(PG8_SB(0, 1), cB + hstepB, voffB); PG8_STAGE(PG8_SA(0, 0), cA, voffA); PG8_STAGE(PG8_SA(0, 1), cA + hstepA, voffA);
    if (wr == 1) PG8_BAR;
    PG8_WAIT_V(2); PG8_BAR;
    PG8_STAGE(PG8_SB(1, 0), cB + kstep, voffB); PG8_STAGE(PG8_SA(1, 0), cA + kstep, voffA); PG8_STAGE(PG8_SB(1, 1), cB + hstepB + kstep, voffB);
    PG8_WAIT_V(6); PG8_BAR;
    for (;;) {
        const bool has_next = S.next(ui + 1, nxt);
        const char* nA = has_next ? nxt.a : cA; const char* nB = has_next ? nxt.b : cB;
#pragma unroll 1
        for (int t = 0; t < nt; t += 2) {
            const bool last = (t == nt - 2);
            const char* a1 = cA + (size_t)(t + 1) * kstep;
            const char* a2 = last ? nA : cA + (size_t)(t + 2) * kstep; const char* b2 = last ? nB : cB + (size_t)(t + 2) * kstep;
            const char* a3 = a2 + kstep; const char* b3 = b2 + kstep;
            PG8_LDB(B0, 0, 0); PG8_LDB(B1, 0, 1); PG8_SCHED; PG8_LDA(At, 0, 0); PG8_STAGE(PG8_SA(1, 1), a1 + hstepA, voffA);
            PG8_WAIT_V(8); PG8_WAIT_L(0); PG8_BAR; PG8_MMA(0, 0, At, B0); PG8_MMA(0, 1, At, B1); PG8_BAR; PG8_SCHED;
            PG8_LDA(At, 0, 1); PG8_STAGE(PG8_SB(0, 0), b2, voffB); PG8_STAGE(PG8_SB(0, 1), b2 + hstepB, voffB); PG8_STAGE(PG8_SA(0, 0), a2, voffA);
            PG8_WAIT_V(8); PG8_WAIT_L(0); PG8_BAR; PG8_MMA(1, 0, At, B0); PG8_MMA(1, 1, At, B1); PG8_BAR; PG8_SCHED;
            PG8_LDB(B0, 1, 0); PG8_LDB(B1, 1, 1); PG8_SCHED; PG8_LDA(At, 1, 0); PG8_STAGE(PG8_SA(0, 1), a2 + hstepA, voffA);
            PG8_WAIT_V(8); PG8_WAIT_L(0); PG8_BAR; PG8_MMA(0, 0, At, B0); PG8_MMA(0, 1, At, B1); PG8_BAR; PG8_SCHED;
            PG8_LDA(At, 1, 1); PG8_STAGE(PG8_SB(1, 0), b3, voffB); PG8_STAGE(PG8_SB(1, 1), b3 + hstepB, voffB); PG8_STAGE(PG8_SA(1, 0), a3, voffA);
            PG8_WAIT_V(8); PG8_WAIT_L(0); PG8_BAR; PG8_MMA(1, 0, At, B0); PG8_MMA(1, 1, At, B1); PG8_BAR; PG8_SCHED;
        }
        if (wr == 0) PG8_BAR;
        if constexpr (!Epi::AFTER_DRAIN) { E(acc, cur, wr, wc, fr, fq); }
        if (!has_next) break;
#pragma unroll
        for (int a = 0; a < 2; ++a)
#pragma unroll
            for (int b = 0; b < 2; ++b)
#pragma unroll
                for (int m = 0; m < 4; ++m)
#pragma unroll
                    for (int n = 0; n < 2; ++n) acc[a][b][m][n] = (f32x4){0.f, 0.f, 0.f, 0.f};
        cur = nxt; cA = nA; cB = nB; ++ui;
        if (wr == 1) PG8_BAR;
    }
    PG8_WAIT_V(0);
    PG8_BAR;
    if constexpr (Epi::AFTER_DRAIN) { E.fused(acc, cur, wr, wc, fr, fq, lds, wid, lane); }
#undef PG8_SA
#undef PG8_SB
#undef PG8_STAGE
#undef PG8_LDA
#undef PG8_LDB
#undef PG8_MMA
#undef PG8_WAIT_V
#undef PG8_WAIT_L
#undef PG8_BAR
#undef PG8_SCHED
}
}
namespace fk {
constexpr int T = 32768, D = 1024, S = 2048, NB = 16, NIN = 2568, NZ = 2560, NWAVES = 8, NTHR = 512;
constexpr int APAD = 65536 + 16 * 256;
constexpr float ALPHA = 1.4142135623730951f, LN_EPS = 1e-5f;
constexpr size_t MiB = 1u << 20;
constexpr size_t WS_CTL = 0, CTL_BYTES = 1 * MiB;
constexpr size_t WS_WIN = 1 * MiB, WS_WOUT = 11 * MiB, WS_WQ = 15 * MiB, WS_WKV = 19 * MiB, WS_WO = 27 * MiB, WS_WGU = 31 * MiB, WS_WD = 63 * MiB;
constexpr size_t WS_GATES = 79 * MiB, WS_EI = 80 * MiB, WS_GT = WS_EI + 256 * 1024, WS_SLOT = WS_GT + 256 * 1024, WS_DEST = WS_SLOT + 256 * 1024;
constexpr size_t WS_GATEG = 81 * MiB, WS_NST = 82 * MiB, WS_MST = 83 * MiB;
constexpr size_t WS_XB = 84 * MiB;
constexpr size_t WS_Z = 148 * MiB, WS_Y = 148 * MiB, WS_XG = 148 * MiB;
constexpr size_t WS_H = 284 * MiB, WS_YB = 318 * MiB;
constexpr size_t WS_CST = 308 * MiB, WS_MIXED = 372 * MiB;
constexpr size_t WS_Q = 276 * MiB, WS_O = 340 * MiB, WS_PSCR = 404 * MiB;
constexpr size_t WS_KV = 454 * MiB;
constexpr size_t WS_MEMB = 486 * MiB, WS_END = 494 * MiB;
constexpr int CW_BAR = 4096;
constexpr int CW_CNT = 16384;
constexpr int RING_BYTES = 131072, MISC_OFF = RING_BYTES + 320, LDS_BYTES = 147456;

struct TileOrder {
    int nM, nN, nwg, G, c;
    __device__ __forceinline__ void init(int nM_, int nN_, int G_, int c_) { nM = nM_; nN = nN_; nwg = nM * nN; G = G_; c = c_; }
    __device__ __forceinline__ bool map(int i, int& pm, int& pn) const {
        const long L = (long)i * G + c; if (L >= nwg) return false;
        int wgid = (int)L; { const int q = nwg / 8, r = nwg % 8, xcd = wgid % 8, off = wgid / 8; wgid = (xcd < r ? xcd * (q + 1) : r * (q + 1) + (xcd - r) * q) + off; }
        const int nig = 8 * nN, gid = wgid / nig, fm = gid * 8, gsz = (nM - fm) < 8 ? (nM - fm) : 8;
        pm = fm + ((wgid % nig) % gsz); pn = (wgid % nig) / gsz; return true;
    }
};
struct SchedPlain {
    TileOrder TO; const char* A; const char* B; char* O; size_t a_tile, b_tile, o_pm, o_pn;
    __device__ __forceinline__ bool next(int i, pg8::Unit& u) const {
        int pm, pn; if (!TO.map(i, pm, pn)) return false;
        u.a = A + (size_t)pm * a_tile; u.b = B + (size_t)pn * b_tile; u.o = O + (size_t)pm * o_pm + (size_t)pn * o_pn; u.aux = pm; u.aux2 = pn; return true;
    }
};
struct SchedOne { pg8::Unit u; __device__ __forceinline__ bool next(int i, pg8::Unit& o) const { if (i != 0) return false; o = u; return true; } };
struct SchedKV {
    int G, c; const char* memb; const char* wkv; char* kv;
    __device__ __forceinline__ bool next(int i, pg8::Unit& u) const {
        const int L = i * G + c; if (L >= 256) return false;
        const int l = L >> 7, kind = (L >> 6) & 1, idx = L & 63;
        const char* w = wkv + (size_t)l * 4 * MiB; char* o = kv + (size_t)l * 16 * MiB;
        if (kind == 0) { const int pm = idx >> 2, pn = idx & 3; u.a = memb + (size_t)pm * 256 * 2048; u.b = w + (size_t)pn * 256 * 2048; u.o = o + ((size_t)pm * 256 * 1024 + pn * 256) * 2; u.aux = 1024; }
        else { const int pm = idx & 3, pn = idx >> 2; u.a = w + (size_t)(1024 + pm * 256) * 2048; u.b = memb + (size_t)pn * 256 * 2048; u.o = o + 8 * MiB + ((size_t)pn * 1024 * 256 + (size_t)pm * 256 * 256) * 2; u.aux = 256; }
        u.aux2 = 0; return true;
    }
};
template <int NPN> struct SchedMoe {
    int G, c, ntot; int tstart[17];
    const char* A; size_t a_tile; const char* W; size_t w_exp, w_pn; char* O; size_t o_tile, o_pn;
    __device__ __forceinline__ void init(const unsigned* cnt  , int G_, int c_) {
        G = G_; c = c_; int s = 0;
#pragma unroll
        for (int e = 0; e < 16; ++e) { tstart[e] = s; s += __builtin_amdgcn_readfirstlane((int)((__hip_atomic_load(cnt + e * 64, RLX_AGENT) + 255u) >> 8)); }
        tstart[16] = s; ntot = s;
    }
    __device__ __forceinline__ bool next(int i, pg8::Unit& u) const {
        const int L = i * G + c; if (L >= ntot * NPN) return false;
        const int tile = L / NPN, pn = L % NPN; int e = 0;
#pragma unroll
        for (int k = 1; k < 16; ++k) e += (tile >= tstart[k]) ? 1 : 0;
        u.a = A + (size_t)tile * a_tile; u.b = W + (size_t)e * w_exp + (size_t)pn * w_pn; u.o = O + (size_t)tile * o_tile + (size_t)pn * o_pn; u.aux = tile; u.aux2 = pn; return true;
    }
};

struct EpiBf16 {
    static constexpr bool PERM = true, AFTER_DRAIN = false; int ldc; float scale;
    __device__ __forceinline__ void operator()(const f32x4 (&acc)[2][2][4][2], const pg8::Unit& u, int wr, int wc, int fr, int fq) const {
        const int ld = ldc ? ldc : u.aux; bf16* base = (bf16*)u.o + (size_t)(wr * 64 + fr) * ld + wc * 32 + 8 * fq;
#pragma unroll
        for (int ai = 0; ai < 2; ++ai)
#pragma unroll
            for (int m = 0; m < 4; ++m) { bf16* rowp = base + (size_t)(ai * 128 + m * 16) * ld;
#pragma unroll
                for (int bj = 0; bj < 2; ++bj) { const f32x4 v0 = acc[ai][bj][m][0] * scale, v1 = acc[ai][bj][m][1] * scale;
                    u32x4 w; w.x = pk2(v0[0], v0[1]); w.y = pk2(v0[2], v0[3]); w.z = pk2(v1[0], v1[1]); w.w = pk2(v1[2], v1[3]);
                    *(u32x4*)(rowp + bj * 128) = w; } }
    }
};
struct EpiRes {
    static constexpr bool PERM = false, AFTER_DRAIN = false; const float* X; float* Y;
    __device__ __forceinline__ void operator()(const f32x4 (&acc)[2][2][4][2], const pg8::Unit& u, int wr, int wc, int fr, int fq) const {
        const size_t o0 = (size_t)(u.aux * 256 + wr * 64 + fr) * 1024 + u.aux2 * 256 + wc * 32 + 4 * fq;
#pragma unroll
        for (int ai = 0; ai < 2; ++ai)
#pragma unroll
            for (int m = 0; m < 4; ++m) { const size_t o1 = o0 + (size_t)(ai * 128 + m * 16) * 1024;
#pragma unroll
                for (int bj = 0; bj < 2; ++bj)
#pragma unroll
                    for (int n = 0; n < 2; ++n) { const size_t o = o1 + bj * 128 + n * 16; const f32x4 x = *(const f32x4*)(X + o); *(f32x4*)(Y + o) = x * ALPHA + acc[ai][bj][m][n]; } }
    }
};
struct EpiSoftmax {
    static constexpr bool PERM = true, AFTER_DRAIN = true;
    __device__ __forceinline__ void fused(f32x4 (&acc)[2][2][4][2], const pg8::Unit& u, int wr, int wc, int fr, int fq, LAS unsigned char* lds, int wid, int lane) const {
        LAS float* RM = (LAS float*)lds;
        LAS float* RS = (LAS float*)(lds + 4096);
#pragma unroll
        for (int ai = 0; ai < 2; ++ai)
#pragma unroll
            for (int m = 0; m < 4; ++m) { float mx = -3.0e38f;
#pragma unroll
                for (int bj = 0; bj < 2; ++bj)
#pragma unroll
                    for (int n = 0; n < 2; ++n) { const f32x4 x = acc[ai][bj][m][n]; mx = fmaxf(mx, fmaxf(fmaxf(x[0], x[1]), fmaxf(x[2], x[3]))); }
                mx = fmaxf(mx, __shfl_xor(mx, 16)); mx = fmaxf(mx, __shfl_xor(mx, 32));
                if (fq == 0) RM[(ai * 128 + wr * 64 + m * 16 + fr) * 4 + wc] = mx; }
        LDS_WAIT(); __builtin_amdgcn_s_barrier(); asm volatile("" ::: "memory");
#pragma unroll
        for (int ai = 0; ai < 2; ++ai)
#pragma unroll
            for (int m = 0; m < 4; ++m) { const int r = ai * 128 + wr * 64 + m * 16 + fr; const f32x4 mm = *(const LAS f32x4*)(RM + r * 4);
                const float mx = fmaxf(fmaxf(mm[0], mm[1]), fmaxf(mm[2], mm[3])); float s = 0.f;
#pragma unroll
                for (int bj = 0; bj < 2; ++bj)
#pragma unroll
                    for (int n = 0; n < 2; ++n) { f32x4 x = acc[ai][bj][m][n]; x[0] = __expf(x[0] - mx); x[1] = __expf(x[1] - mx); x[2] = __expf(x[2] - mx); x[3] = __expf(x[3] - mx); acc[ai][bj][m][n] = x; s += (x[0] + x[1]) + (x[2] + x[3]); }
                s += __shfl_xor(s, 16); s += __shfl_xor(s, 32);
                if (fq == 0) RS[r * 4 + wc] = s; }
        LDS_WAIT(); __builtin_amdgcn_s_barrier(); asm volatile("" ::: "memory");
        bf16* base = (bf16*)u.o + (size_t)(wr * 64 + fr) * 256 + wc * 32 + 8 * fq;
#pragma unroll
        for (int ai = 0; ai < 2; ++ai)
#pragma unroll
            for (int m = 0; m < 4; ++m) { const int r = ai * 128 + wr * 64 + m * 16 + fr; const f32x4 ss = *(const LAS f32x4*)(RS + r * 4);
                const float inv = 1.f / ((ss[0] + ss[1]) + (ss[2] + ss[3])); bf16* rowp = base + (size_t)(ai * 128 + m * 16) * 256;
#pragma unroll
                for (int bj = 0; bj < 2; ++bj) { const f32x4 v0 = acc[ai][bj][m][0] * inv, v1 = acc[ai][bj][m][1] * inv;
                    u32x4 w; w.x = pk2(v0[0], v0[1]); w.y = pk2(v0[2], v0[3]); w.z = pk2(v1[0], v1[1]); w.w = pk2(v1[2], v1[3]);
                    *(u32x4*)(rowp + bj * 128) = w; } }
    }
};
struct EpiSiluMul {
    static constexpr bool PERM = true, AFTER_DRAIN = false;
    __device__ __forceinline__ void operator()(const f32x4 (&acc)[2][2][4][2], const pg8::Unit& u, int wr, int wc, int fr, int fq) const {
        bf16* base = (bf16*)u.o + (size_t)(wr * 64 + fr) * 256 + wc * 32 + 8 * fq;
#pragma unroll
        for (int ai = 0; ai < 2; ++ai)
#pragma unroll
            for (int m = 0; m < 4; ++m) { f32x4 h0, h1;
#pragma unroll
                for (int k = 0; k < 4; ++k) { h0[k] = silu(acc[ai][0][m][0][k]) * acc[ai][1][m][0][k]; h1[k] = silu(acc[ai][0][m][1][k]) * acc[ai][1][m][1][k]; }
                u32x4 w; w.x = pk2(h0[0], h0[1]); w.y = pk2(h0[2], h0[3]); w.z = pk2(h1[0], h1[1]); w.w = pk2(h1[2], h1[3]);
                *(u32x4*)(base + (size_t)(ai * 128 + m * 16) * 256) = w; }
    }
};
struct EpiMoeDown {
    static constexpr bool PERM = true, AFTER_DRAIN = false; const float* gateg;
    __device__ __forceinline__ void operator()(const f32x4 (&acc)[2][2][4][2], const pg8::Unit& u, int wr, int wc, int fr, int fq) const {
        bf16* base = (bf16*)u.o + (size_t)(wr * 64 + fr) * 1024 + wc * 32 + 8 * fq; const float* gp = gateg + (size_t)u.aux * 256 + wr * 64 + fr;
#pragma unroll
        for (int ai = 0; ai < 2; ++ai)
#pragma unroll
            for (int m = 0; m < 4; ++m) { const float gt = gp[ai * 128 + m * 16]; bf16* rowp = base + (size_t)(ai * 128 + m * 16) * 1024;
#pragma unroll
                for (int bj = 0; bj < 2; ++bj) { const f32x4 v0 = acc[ai][bj][m][0] * gt, v1 = acc[ai][bj][m][1] * gt;
                    u32x4 w; w.x = pk2(v0[0], v0[1]); w.y = pk2(v0[2], v0[3]); w.z = pk2(v1[0], v1[1]); w.w = pk2(v1[2], v1[3]);
                    *(u32x4*)(rowp + bj * 128) = w; } }
    }
};
}
namespace fk {
struct Args { const float* in[24]; float* out; unsigned char* ws; int ph_lo, ph_hi; };

template <class RowMap>
__device__ __forceinline__ void tr_item(const float* W, int ldw, bf16* WT, int ldt, int k0, int n0, RowMap rm, LAS float* scr, int lane) {
#pragma unroll 8
    for (int i = 0; i < 32; ++i) { const int kk = 2 * i + (lane >> 5); scr[kk * 33 + (lane & 31)] = W[(size_t)(k0 + kk) * ldw + n0 + (lane & 31)]; }
    LDS_WAIT(); asm volatile("" ::: "memory");
    const int c = lane & 7;
#pragma unroll
    for (int j = 0; j < 4; ++j) { const int n = (lane >> 3) + 8 * j; const LAS float* s = scr + (8 * c) * 33 + n;
        u32x4 o; o.x = pk2(s[0 * 33], s[1 * 33]); o.y = pk2(s[2 * 33], s[3 * 33]); o.z = pk2(s[4 * 33], s[5 * 33]); o.w = pk2(s[6 * 33], s[7 * 33]);
        *(u32x4*)(WT + (size_t)rm(n0 + n) * ldt + k0 + 8 * c) = o; }
    LDS_WAIT(); asm volatile("" ::: "memory");
}
struct RmId { __device__ __forceinline__ int operator()(int n) const { return n; } };
struct RmGate { int off; __device__ __forceinline__ int operator()(int n) const { return ((n >> 7) << 8) + (n & 127) + off; } };

__device__ __forceinline__ void p0_prologue(const Args& a, LAS unsigned char* lds, int vcu, int G) {
    int tid = threadIdx.x; asm volatile("" : "+v"(tid)); const int lane = tid & 63, wave = __builtin_amdgcn_readfirstlane(tid >> 6);
    unsigned char* ws = a.ws;
    for (int it = vcu; it < 128; it += G) {
        const int l = it >> 6, g = (it >> 4) & 3, kb = it & 15, d = tid & 127, kq = tid >> 7;
        const float* win = a.in[2] + (size_t)l * D * NIN; const float* pw = a.in[7] + (size_t)l * 65536 + (size_t)g * 16384; const float psn = a.in[8][l * 512 + g * 128 + d];
        float acc[16];
#pragma unroll
        for (int i = 0; i < 16; ++i) acc[i] = 0.f;
        const float* wrow = win + (size_t)(kb * 64 + kq * 16) * NIN + 2056 + g * 128;
        for (int c = 0; c < 128; ++c) { const float p = pw[(size_t)c * 128 + d];
#pragma unroll
            for (int i = 0; i < 16; ++i) acc[i] = fmaf(wrow[(size_t)i * NIN + c], p, acc[i]); }
        bf16* dst = (bf16*)(ws + WS_WIN) + (size_t)l * NZ * 1024 + (size_t)(2048 + g * 128 + d) * 1024 + kb * 64 + kq * 16;
        u32x4 o0, o1;
        o0.x = pk2(acc[0] * psn, acc[1] * psn); o0.y = pk2(acc[2] * psn, acc[3] * psn); o0.z = pk2(acc[4] * psn, acc[5] * psn); o0.w = pk2(acc[6] * psn, acc[7] * psn);
        o1.x = pk2(acc[8] * psn, acc[9] * psn); o1.y = pk2(acc[10] * psn, acc[11] * psn); o1.z = pk2(acc[12] * psn, acc[13] * psn); o1.w = pk2(acc[14] * psn, acc[15] * psn);
        *(u32x4*)dst = o0; *(u32x4*)(dst + 8) = o1;
    }
    LAS float* scr = (LAS float*)(lds + wave * 16384);
    const int gw = vcu * NWAVES + wave, NGW = G * NWAVES;
    constexpr int PER_LAYER = 1024 + 512 + 512 + 1024 + 512 + 3 * 2048;
    for (int it = gw; it < 2 * PER_LAYER; it += NGW) {
        const int l = it / PER_LAYER; int r = it % PER_LAYER;
        if (r < 1024) { tr_item(a.in[2] + (size_t)l * D * NIN, NIN, (bf16*)(ws + WS_WIN) + (size_t)l * NZ * 1024, 1024, (r >> 6) * 64, (r & 63) * 32, RmId{}, scr, lane); continue; } r -= 1024;
        if (r < 512) { tr_item(a.in[9] + (size_t)l * D * D, D, (bf16*)(ws + WS_WOUT) + (size_t)l * D * D, 1024, (r >> 5) * 64, (r & 31) * 32, RmId{}, scr, lane); continue; } r -= 512;
        if (r < 512) { tr_item(a.in[12] + (size_t)l * D * D, D, (bf16*)(ws + WS_WQ) + (size_t)l * D * D, 1024, (r >> 5) * 64, (r & 31) * 32, RmId{}, scr, lane); continue; } r -= 512;
        if (r < 1024) { tr_item(a.in[13] + (size_t)l * D * 2 * D, 2 * D, (bf16*)(ws + WS_WKV) + (size_t)l * 2 * D * D, 1024, (r >> 6) * 64, (r & 63) * 32, RmId{}, scr, lane); continue; } r -= 1024;
        if (r < 512) { tr_item(a.in[14] + (size_t)l * D * D, D, (bf16*)(ws + WS_WO) + (size_t)l * D * D, 1024, (r >> 5) * 64, (r & 31) * 32, RmId{}, scr, lane); continue; } r -= 512;
        if (r < 2048) { const int e = r >> 7, q = r & 127; tr_item(a.in[19] + ((size_t)l * 16 + e) * 1024 * 256, 256, (bf16*)(ws + WS_WGU) + ((size_t)l * 16 + e) * 512 * 1024, 1024, (q >> 3) * 64, (q & 7) * 32, RmGate{0}, scr, lane); continue; } r -= 2048;
        if (r < 2048) { const int e = r >> 7, q = r & 127; tr_item(a.in[20] + ((size_t)l * 16 + e) * 1024 * 256, 256, (bf16*)(ws + WS_WGU) + ((size_t)l * 16 + e) * 512 * 1024, 1024, (q >> 3) * 64, (q & 7) * 32, RmGate{128}, scr, lane); continue; } r -= 2048;
        { const int e = r >> 7, q = r & 127; tr_item(a.in[21] + ((size_t)l * 16 + e) * 256 * 1024, 1024, (bf16*)(ws + WS_WD) + ((size_t)l * 16 + e) * 1024 * 256, 256, (q >> 5) * 64, (q & 31) * 32, RmId{}, scr, lane); }
    }
    { const f32x4* src = (const f32x4*)a.in[1]; u32x2* dst = (u32x2*)(ws + WS_MEMB); const int n4 = NB * 256 * D / 4;
      for (int i = vcu * NTHR + tid; i < n4; i += G * NTHR) { const f32x4 v = src[i]; u32x2 o; o.x = pk2(v[0], v[1]); o.y = pk2(v[2], v[3]); dst[i] = o; } }
}

template <int MODE>
__device__ __forceinline__ void rowpass(const Args& a, LAS unsigned char* lds, int vcu, int G,
                                        const float* src, const float* lng, const float* lnb, const float* gates_w  , const float* gb_i, const float* gb_f, int layer) {
    int tid = threadIdx.x; asm volatile("" : "+v"(tid)); const int lane = tid & 63, wave = __builtin_amdgcn_readfirstlane(tid >> 6);
    unsigned char* ws = a.ws;
    float* XF = a.out; bf16* XB = (bf16*)(ws + WS_XB); float* GATES = (float*)(ws + WS_GATES);
    LAS float* WL = (LAS float*)lds;
    constexpr int NOUT = (MODE == 2) ? 16 : 8;
    const bool do_mv = (MODE == 2) || (gates_w != nullptr);
    if (MODE == 2) { const float* rw = a.in[17]; for (int idx = tid; idx < 16384; idx += NTHR) WL[(idx & 15) * 1024 + (idx >> 4)] = rw[idx]; }
    else if (do_mv) { for (int idx = tid; idx < 8192; idx += NTHR) WL[(idx & 7) * 1024 + (idx >> 3)] = gates_w[(size_t)(idx >> 3) * NIN + 2048 + (idx & 7)]; }
    LAS int* EIL = (LAS int*)(lds + 65536); LAS int* HIST = (LAS int*)(lds + 65536 + 1024); LAS int* BASE = (LAS int*)(lds + 65536 + 1024 + 64); LAS float* GTL = (LAS float*)(lds + 65536 + 2048);
    __syncthreads();
    for (int blk = vcu; blk < T / 128; blk += G) {
        if (MODE == 2) { if (tid < 16) HIST[tid] = 0; }
        for (int rr = 0; rr < 16; ++rr) {
            const int row = blk * 128 + wave * 16 + rr;
            f32x4 v[4];
            if (MODE == 3) {
                const int* DEST = (const int*)(ws + WS_DEST); const int d0 = DEST[2 * row], d1 = DEST[2 * row + 1];
                const bf16* YB = (const bf16*)(ws + WS_YB);
#pragma unroll
                for (int j = 0; j < 4; ++j) { const f32x4 x = *(const f32x4*)(XF + (size_t)row * 1024 + 4 * lane + 256 * j);
                    const u32x2 y0 = *(const u32x2*)(YB + (size_t)d0 * 1024 + 4 * lane + 256 * j), y1 = *(const u32x2*)(YB + (size_t)d1 * 1024 + 4 * lane + 256 * j);
                    v[j][0] = x[0] * ALPHA + (bflo(y0.x) + bflo(y1.x)); v[j][1] = x[1] * ALPHA + (bfhi(y0.x) + bfhi(y1.x));
                    v[j][2] = x[2] * ALPHA + (bflo(y0.y) + bflo(y1.y)); v[j][3] = x[3] * ALPHA + (bfhi(y0.y) + bfhi(y1.y)); }
            } else {
#pragma unroll
                for (int j = 0; j < 4; ++j) v[j] = *(const f32x4*)(src + (size_t)row * 1024 + 4 * lane + 256 * j);
            }
            if (MODE != 0) {
                float s = 0.f;
#pragma unroll
                for (int j = 0; j < 4; ++j) s += (v[j][0] + v[j][1]) + (v[j][2] + v[j][3]);
                const float mean = wave_sum(s) * (1.f / 1024.f); float q = 0.f;
#pragma unroll
                for (int j = 0; j < 4; ++j) { v[j] = v[j] - mean; q += (v[j][0] * v[j][0] + v[j][1] * v[j][1]) + (v[j][2] * v[j][2] + v[j][3] * v[j][3]); }
                const float rstd = rsqrtf(wave_sum(q) * (1.f / 1024.f) + LN_EPS);
#pragma unroll
                for (int j = 0; j < 4; ++j) { const f32x4 gg = *(const f32x4*)(lng + 4 * lane + 256 * j), bb = *(const f32x4*)(lnb + 4 * lane + 256 * j); v[j] = v[j] * rstd * gg + bb;
                    *(f32x4*)(XF + (size_t)row * 1024 + 4 * lane + 256 * j) = v[j]; }
            }
            if (MODE != 3 || do_mv) {
#pragma unroll
                for (int j = 0; j < 4; ++j) { u32x2 o; o.x = pk2(v[j][0], v[j][1]); o.y = pk2(v[j][2], v[j][3]); *(u32x2*)(XB + (size_t)row * 1024 + 4 * lane + 256 * j) = o; }
            }
            if (do_mv) {
                float lg[NOUT];
#pragma unroll
                for (int e = 0; e < NOUT; ++e) { float p = 0.f;
#pragma unroll
                    for (int j = 0; j < 4; ++j) { const f32x4 w = *(const LAS f32x4*)(WL + e * 1024 + 4 * lane + 256 * j); p += (v[j][0] * w[0] + v[j][1] * w[1]) + (v[j][2] * w[2] + v[j][3] * w[3]); }
                    lg[e] = wave_sum(p); }
                if (MODE == 2) {
                    const float* rb = a.in[18];
                    float bestv = 0.f, g1 = 0.f, g2 = 0.f; int e1 = 0, e2 = 0;
#pragma unroll
                    for (int g = 0; g < 4; ++g) {
                        float sc[4], sel[4];
#pragma unroll
                        for (int i = 0; i < 4; ++i) { sc[i] = 1.f / (1.f + expf(-lg[4 * g + i])); sel[i] = sc[i] + rb[4 * g + i]; }
                        int i1 = 0; float v1 = sel[0], s1 = sc[0];
#pragma unroll
                        for (int i = 1; i < 4; ++i) if (sel[i] > v1) { v1 = sel[i]; i1 = i; s1 = sc[i]; }
                        int i2 = 0; float v2 = -3.0e38f, s2 = 0.f;
#pragma unroll
                        for (int i = 0; i < 4; ++i) if (i != i1 && sel[i] > v2) { v2 = sel[i]; i2 = i; s2 = sc[i]; }
                        const float gs = v1 + v2;
                        if (g == 0 || gs > bestv) { bestv = gs; e1 = 4 * g + i1; e2 = 4 * g + i2; g1 = s1; g2 = s2; }
                    }
                    const float inv = 1.f / (g1 + g2);
                    if (lane == 0) { const int lr = wave * 16 + rr; EIL[2 * lr] = e1; EIL[2 * lr + 1] = e2; GTL[2 * lr] = g1 * inv; GTL[2 * lr + 1] = g2 * inv; }
                } else {
                    if (lane == 0) {
#pragma unroll
                        for (int e = 0; e < 4; ++e) { GATES[(size_t)row * 8 + e] = lg[e] + gb_i[e]; GATES[(size_t)row * 8 + 4 + e] = lg[4 + e] + gb_f[e]; }
                    }
                }
            }
        }
        if (MODE == 2) {
            __syncthreads();
            int e = 0, ls = 0;
            if (tid < 256) { e = EIL[tid]; ls = atomicAdd((int*)&HIST[e], 1); }
            __syncthreads();
            if (tid < 16) BASE[tid] = (int)__hip_atomic_fetch_add((unsigned*)(ws + WS_CTL) + CW_CNT + (layer * 16 + tid) * 64, (unsigned)HIST[tid], RLX_AGENT);
            __syncthreads();
            if (tid < 256) { const int as = blk * 256 + tid; ((int*)(ws + WS_EI))[as] = e; ((int*)(ws + WS_SLOT))[as] = BASE[e] + ls; ((float*)(ws + WS_GT))[as] = GTL[tid]; }
            __syncthreads();
        }
    }
}

__device__ __forceinline__ void conv8(const bf16* zrow  , int tpos  , const float* cw  , float (&out)[8]) {
    float acc[8];
#pragma unroll
    for (int c = 0; c < 8; ++c) acc[c] = 0.f;
#pragma unroll
    for (int j = 0; j < 4; ++j) {
        const int dt = 3 - j;
        u32x4 z = (u32x4){0u, 0u, 0u, 0u};
        if (tpos - dt >= 0) z = *(const u32x4*)(zrow - (size_t)dt * NZ);
        const f32x4 w0 = *(const f32x4*)(cw + j * 1024), w1 = *(const f32x4*)(cw + j * 1024 + 4);
        acc[0] = fmaf(bflo(z.x), w0[0], acc[0]); acc[1] = fmaf(bfhi(z.x), w0[1], acc[1]); acc[2] = fmaf(bflo(z.y), w0[2], acc[2]); acc[3] = fmaf(bfhi(z.y), w0[3], acc[3]);
        acc[4] = fmaf(bflo(z.z), w1[0], acc[4]); acc[5] = fmaf(bfhi(z.z), w1[1], acc[5]); acc[6] = fmaf(bflo(z.w), w1[2], acc[6]); acc[7] = fmaf(bfhi(z.w), w1[3], acc[7]);
    }
#pragma unroll
    for (int c = 0; c < 8; ++c) out[c] = silu(acc[c]);
}
__device__ __forceinline__ float wave_incl_sum(float v, int lane) {
#pragma unroll
    for (int o = 1; o < 64; o <<= 1) { const float t = __shfl_up(v, o); if (lane >= o) v += t; }
    return v;
}
__device__ __forceinline__ float wave_incl_max(float v, int lane) {
#pragma unroll
    for (int o = 1; o < 64; o <<= 1) { const float t = __shfl_up(v, o); if (lane >= o) v = fmaxf(v, t); }
    return v;
}

__device__ __forceinline__ void p2_pool_state(const Args& a, LAS unsigned char* lds, int vcu, int G, int layer) {
    int tid = threadIdx.x; asm volatile("" : "+v"(tid)); const int lane = tid & 63, wave = __builtin_amdgcn_readfirstlane(tid >> 6);
    unsigned char* ws = a.ws; const bf16* Z = (const bf16*)(ws + WS_Z); bf16* MIX = (bf16*)(ws + WS_MIXED); const float* GATES = (const float*)(ws + WS_GATES);
    for (int blk = vcu; blk < T / 128; blk += G) {
        const int row0 = blk * 128, t0 = row0 & (S - 1), ch = tid, w = 2 << (ch >> 7);
        const bf16* zc = Z + 2048 + ch; float sum = 0.f;
        for (int r = 1; r < w; ++r) if (t0 - r >= 0) sum += bf2f(zc[(size_t)(row0 - r) * NZ]);
        for (int i = 0; i < 128; ++i) {
            const int t = t0 + i; const float u = bf2f(zc[(size_t)(row0 + i) * NZ]);
            sum += u;
            const float o = sum / (float)min(t + 1, w) - u;
            MIX[(size_t)(row0 + i) * 1024 + 512 + ch] = (bf16)f2bf(o);
            if (t - (w - 1) >= 0) sum -= bf2f(zc[(size_t)(row0 + i - (w - 1)) * NZ]);
        }
    }
    constexpr int KTP = 72;
    LAS bf16* KT = (LAS bf16*)lds; LAS bf16* VT = (LAS bf16*)(lds + 128 * KTP * 2);
    const float* cwl = a.in[5] + (size_t)layer * 4096;
    bf16* CST = (bf16*)(ws + WS_CST); float* NST = (float*)(ws + WS_NST); float* MST = (float*)(ws + WS_MST);
    const int fr = lane & 15, fq = lane >> 4;
    for (int u = vcu; u < 256; u += G) {
        const int bh = u >> 2, es = u & 3, b = bh >> 2, h = bh & 3;
        f32x4 C[2]; C[0] = (f32x4){0.f, 0.f, 0.f, 0.f}; C[1] = C[0];
        float nst = 0.f, m = 0.f;
        for (int c = 0; c < 32; ++c) {
            const int trow0 = b * S + c * 64, chunk = bh * 32 + c;
            const float fpre = GATES[(size_t)(trow0 + lane) * 8 + 4 + h], ig = GATES[(size_t)(trow0 + lane) * 8 + h];
            const float bc = wave_incl_sum(logsig(fpre), lane), blast = __shfl(bc, 63);
            const float wst = blast - bc + ig, mloc = wave_max(wst), al = __expf(wst - mloc);
            const float mnew = fmaxf(blast + m, mloc), s_old = __expf(blast + m - mnew), s_new = __expf(mloc - mnew);
#pragma unroll
            for (int i = 0; i < 2; ++i) {
                const int l = (tid >> 4) + 32 * i, dg = tid & 15; float kv[8];
                conv8(Z + (size_t)(trow0 + l) * NZ + 512 + h * 128 + 8 * dg, c * 64 + l, cwl + 512 + h * 128 + 8 * dg, kv);
                const float sc = __shfl(al, l);
#pragma unroll
                for (int j = 0; j < 8; ++j) KT[(8 * dg + j) * KTP + l] = (bf16)f2bf(kv[j] * sc);
            }
            if (tid < 256) { const int s = tid >> 2, eg = tid & 3; const u32x4 z = *(const u32x4*)(Z + (size_t)(trow0 + s) * NZ + 1024 + h * 128 + es * 32 + 8 * eg);
                LAS bf16* vp = VT + (8 * eg) * KTP + s;
                vp[0] = (bf16)(z.x & 0xffffu); vp[KTP] = (bf16)(z.x >> 16); vp[2 * KTP] = (bf16)(z.y & 0xffffu); vp[3 * KTP] = (bf16)(z.y >> 16);
                vp[4 * KTP] = (bf16)(z.z & 0xffffu); vp[5 * KTP] = (bf16)(z.z >> 16); vp[6 * KTP] = (bf16)(z.w & 0xffffu); vp[7 * KTP] = (bf16)(z.w >> 16); }
            __syncthreads();
            f32x4 CL[2]; CL[0] = (f32x4){0.f, 0.f, 0.f, 0.f}; CL[1] = CL[0];
#pragma unroll
            for (int kk = 0; kk < 2; ++kk) { const bf16x8 af = *(const LAS bf16x8*)(KT + (16 * wave + fr) * KTP + kk * 32 + fq * 8);
#pragma unroll
                for (int et = 0; et < 2; ++et) { const bf16x8 bfg = *(const LAS bf16x8*)(VT + (16 * et + fr) * KTP + kk * 32 + fq * 8);
                    CL[et] = __builtin_amdgcn_mfma_f32_16x16x32_bf16(af, bfg, CL[et], 0, 0, 0); } }
            float nloc = 0.f;
            if (es == 0 && tid < 128) {
#pragma unroll
                for (int q = 0; q < 8; ++q) { const u32x4 kq = *(const LAS u32x4*)(KT + tid * KTP + 8 * q);
                    nloc += (bflo(kq.x) + bfhi(kq.x)) + (bflo(kq.y) + bfhi(kq.y)) + (bflo(kq.z) + bfhi(kq.z)) + (bflo(kq.w) + bfhi(kq.w)); }
                NST[(size_t)chunk * 128 + tid] = nst;
                if (tid == 0) MST[chunk] = m;
            }
#pragma unroll
            for (int et = 0; et < 2; ++et) {
                u32x2 o; o.x = pk2(C[et][0], C[et][1]); o.y = pk2(C[et][2], C[et][3]);
                *(u32x2*)(CST + ((size_t)chunk * 128 + es * 32 + et * 16 + fr) * 128 + 16 * wave + 4 * fq) = o;
                C[et] = C[et] * s_old + CL[et] * s_new;
            }
            nst = nst * s_old + nloc * s_new; m = mnew;
            __syncthreads();
        }
    }
}

__device__ __forceinline__ void p3_mlstm_out(const Args& a, LAS unsigned char* lds, int vcu, int G, int layer) {
    int tid = threadIdx.x; asm volatile("" : "+v"(tid)); const int lane = tid & 63, wave = __builtin_amdgcn_readfirstlane(tid >> 6);
    unsigned char* ws = a.ws; const bf16* Z = (const bf16*)(ws + WS_Z); bf16* MIX = (bf16*)(ws + WS_MIXED); const float* GATES = (const float*)(ws + WS_GATES);
    const bf16* CST = (const bf16*)(ws + WS_CST); const float* NST = (const float*)(ws + WS_NST); const float* MST = (const float*)(ws + WS_MST);
    const float* cwl = a.in[5] + (size_t)layer * 4096; const float* hng = a.in[6] + (size_t)layer * 512;
    constexpr int QP = 136, VP = 72, AP = 200, HP = 132;
    LAS bf16* QS = (LAS bf16*)lds; LAS bf16* KS = (LAS bf16*)(lds + 17408); LAS float* HB = (LAS float*)lds;
    LAS bf16* VT = (LAS bf16*)(lds + 34816); LAS bf16* CT = (LAS bf16*)(lds + 53248); LAS bf16* A2 = (LAS bf16*)(lds + 88064);
    LAS float* SU = (LAS float*)(lds + 113664); LAS float* SG = SU + 64; LAS float* SEN = SU + 128; LAS float* SDEN = SU + 192; LAS float* NP = SU + 256;
    const int fr = lane & 15, fq = lane >> 4;
    for (int u = vcu; u < 2048; u += G) {
        const int bh = u >> 5, c = u & 31, b = bh >> 2, h = bh & 3, trow0 = b * S + c * 64, chunk = u;
        const float fpre = GATES[(size_t)(trow0 + lane) * 8 + 4 + h], ig = GATES[(size_t)(trow0 + lane) * 8 + h];
        const float bc = wave_incl_sum(logsig(fpre), lane), ul = ig - bc, mprev = MST[chunk];
        const float gl = fmaxf(mprev, wave_incl_max(ul, lane)), inter = __expf(mprev - gl);
        if (wave == 0) { SU[lane] = ul; SG[lane] = gl; SEN[lane] = __expf(-(bc + gl)); }
        if (tid < 128) NP[tid] = NST[(size_t)chunk * 128 + tid];
#pragma unroll
        for (int i = 0; i < 2; ++i) {
            const int l = (tid >> 4) + 32 * i, dg = tid & 15; float qv[8], kv[8];
            conv8(Z + (size_t)(trow0 + l) * NZ + h * 128 + 8 * dg, c * 64 + l, cwl + h * 128 + 8 * dg, qv);
            conv8(Z + (size_t)(trow0 + l) * NZ + 512 + h * 128 + 8 * dg, c * 64 + l, cwl + 512 + h * 128 + 8 * dg, kv);
            const float it = __shfl(inter, l);
#pragma unroll
            for (int j = 0; j < 8; ++j) qv[j] *= 0.08838834764831845f;
            u32x4 o; o.x = pk2(qv[0], qv[1]); o.y = pk2(qv[2], qv[3]); o.z = pk2(qv[4], qv[5]); o.w = pk2(qv[6], qv[7]);
            *(LAS u32x4*)(QS + l * QP + 8 * dg) = o;
            o.x = pk2(qv[0] * it, qv[1] * it); o.y = pk2(qv[2] * it, qv[3] * it); o.z = pk2(qv[4] * it, qv[5] * it); o.w = pk2(qv[6] * it, qv[7] * it);
            *(LAS u32x4*)(A2 + l * AP + 64 + 8 * dg) = o;
            o.x = pk2(kv[0], kv[1]); o.y = pk2(kv[2], kv[3]); o.z = pk2(kv[4], kv[5]); o.w = pk2(kv[6], kv[7]);
            *(LAS u32x4*)(KS + l * QP + 8 * dg) = o;
            const u32x4 z = *(const u32x4*)(Z + (size_t)(trow0 + l) * NZ + 1024 + h * 128 + 8 * dg);
            LAS bf16* vp = VT + (8 * dg) * VP + l;
            vp[0] = (bf16)(z.x & 0xffffu); vp[VP] = (bf16)(z.x >> 16); vp[2 * VP] = (bf16)(z.y & 0xffffu); vp[3 * VP] = (bf16)(z.y >> 16);
            vp[4 * VP] = (bf16)(z.z & 0xffffu); vp[5 * VP] = (bf16)(z.z >> 16); vp[6 * VP] = (bf16)(z.w & 0xffffu); vp[7 * VP] = (bf16)(z.w >> 16);
        }
#pragma unroll
        for (int i = 0; i < 4; ++i) { const int p = tid + 512 * i, e = p >> 4, dq = p & 15; *(LAS u32x4*)(CT + e * QP + 8 * dq) = *(const u32x4*)(CST + ((size_t)chunk * 128 + e) * 128 + 8 * dq); }
        __syncthreads();
        { const int rt = wave >> 1, ctb = (wave & 1) * 2;
#pragma unroll
          for (int cc = 0; cc < 2; ++cc) { const int ct = ctb + cc; f32x4 acc = (f32x4){0.f, 0.f, 0.f, 0.f};
#pragma unroll
            for (int kk = 0; kk < 4; ++kk) { const bf16x8 af = *(const LAS bf16x8*)(QS + (16 * rt + fr) * QP + kk * 32 + fq * 8), bfg = *(const LAS bf16x8*)(KS + (16 * ct + fr) * QP + kk * 32 + fq * 8);
                acc = __builtin_amdgcn_mfma_f32_16x16x32_bf16(af, bfg, acc, 0, 0, 0); }
            const int s = 16 * ct + fr; const float us = SU[s];
#pragma unroll
            for (int r = 0; r < 4; ++r) { const int l = 16 * rt + 4 * fq + r; const float p = (s <= l) ? acc[r] * __expf(us - SG[l]) : 0.f; A2[l * AP + s] = (bf16)f2bf(p); } } }
        __syncthreads();
        f32x4 nacc[4];
        { const int rt = wave >> 1, ctb = (wave & 1) * 4;
#pragma unroll
          for (int j = 0; j < 4; ++j) nacc[j] = (f32x4){0.f, 0.f, 0.f, 0.f};
#pragma unroll
          for (int kk = 0; kk < 6; ++kk) { const bf16x8 af = *(const LAS bf16x8*)(A2 + (16 * rt + fr) * AP + kk * 32 + fq * 8);
#pragma unroll
            for (int j = 0; j < 4; ++j) { const int ct = ctb + j;
                const bf16x8 bfg = (kk < 2) ? *(const LAS bf16x8*)(VT + (16 * ct + fr) * VP + kk * 32 + fq * 8) : *(const LAS bf16x8*)(CT + (16 * ct + fr) * QP + (kk - 2) * 32 + fq * 8);
                nacc[j] = __builtin_amdgcn_mfma_f32_16x16x32_bf16(af, bfg, nacc[j], 0, 0, 0); } } }
        { const int l = tid >> 3, part = tid & 7; float dsum = 0.f;
#pragma unroll
          for (int q = 0; q < 3; ++q) { const int j0 = part * 24 + q * 8; const u32x4 av = *(const LAS u32x4*)(A2 + l * AP + j0);
            float w[8];
#pragma unroll
            for (int j = 0; j < 8; ++j) w[j] = (j0 + j < 64) ? 1.f : NP[j0 + j - 64];
            dsum += bflo(av.x) * w[0] + bfhi(av.x) * w[1] + bflo(av.y) * w[2] + bfhi(av.y) * w[3] + bflo(av.z) * w[4] + bfhi(av.z) * w[5] + bflo(av.w) * w[6] + bfhi(av.w) * w[7]; }
          dsum += __shfl_xor(dsum, 1); dsum += __shfl_xor(dsum, 2); dsum += __shfl_xor(dsum, 4);
          if (part == 0) SDEN[l] = dsum; }
        __syncthreads();
        { const int rt = wave >> 1, ctb = (wave & 1) * 4;
#pragma unroll
          for (int r = 0; r < 4; ++r) { const int l = 16 * rt + 4 * fq + r; const float dn = 1.f / fmaxf(fabsf(SDEN[l]), SEN[l]);
#pragma unroll
            for (int j = 0; j < 4; ++j) HB[l * HP + 16 * (ctb + j) + fr] = nacc[j][r] * dn; } }
        __syncthreads();
#pragma unroll
        for (int r = 0; r < 8; ++r) { const int l = 8 * wave + r; const f32x2 hv = *(const LAS f32x2*)(HB + l * HP + 2 * lane);
            const float mean = wave_sum(hv[0] + hv[1]) * (1.f / 128.f), d0 = hv[0] - mean, d1 = hv[1] - mean;
            const float rs = rsqrtf(wave_sum(d0 * d0 + d1 * d1) * (1.f / 128.f) + LN_EPS);
            const unsigned ow = *(const unsigned*)(Z + (size_t)(trow0 + l) * NZ + 1536 + h * 128 + 2 * lane);
            const f32x2 gg = *(const f32x2*)(hng + h * 128 + 2 * lane);
            *(unsigned*)(MIX + (size_t)(trow0 + l) * 1024 + h * 128 + 2 * lane) = pk2(d0 * rs * gg[0] * sigm(bflo(ow)), d1 * rs * gg[1] * sigm(bfhi(ow))); }
        __syncthreads();
    }
}

__device__ __forceinline__ void p10a_gather(const Args& a, LAS unsigned char* lds, int vcu, int G, int layer) {
    int tid = threadIdx.x; asm volatile("" : "+v"(tid)); const int lane = tid & 63, wave = __builtin_amdgcn_readfirstlane(tid >> 6);
    unsigned char* ws = a.ws; const unsigned* cnt = (const unsigned*)(ws + WS_CTL) + CW_CNT + layer * 16 * 64;
    LAS int* PST = (LAS int*)lds; LAS int* DL = (LAS int*)(lds + 256);
    if (tid == 0) { int s = 0; for (int e = 0; e < 16; ++e) { PST[e] = s; s += (int)(((__hip_atomic_load(cnt + e * 64, RLX_AGENT) + 255u) >> 8) << 8); } }
    __syncthreads();
    const bf16* XB = (const bf16*)(ws + WS_XB); bf16* XG = (bf16*)(ws + WS_XG);
    for (int blk = vcu; blk < T / 128; blk += G) {
        if (tid < 256) { const int as = blk * 256 + tid; const int e = ((const int*)(ws + WS_EI))[as]; const int d = PST[e] + ((const int*)(ws + WS_SLOT))[as];
            ((int*)(ws + WS_DEST))[as] = d; ((float*)(ws + WS_GATEG))[d] = ((const float*)(ws + WS_GT))[as]; DL[tid] = d; }
        __syncthreads();
        for (int r = wave; r < 256; r += NWAVES) { const int row = blk * 128 + (r >> 1), d = DL[r];
            const u32x4* s = (const u32x4*)(XB + (size_t)row * 1024); u32x4* o = (u32x4*)(XG + (size_t)d * 1024);
            o[lane] = s[lane]; o[lane + 64] = s[lane + 64]; }
        __syncthreads();
    }
}

__global__ void __launch_bounds__(NTHR, 2) mk_fwd(Args a) {
    extern __shared__ __attribute__((aligned(16))) unsigned char lds_[];
    LAS unsigned char* lds = (LAS unsigned char*)lds_;
    const int tid = threadIdx.x, lane = tid & 63, wave = __builtin_amdgcn_readfirstlane(tid >> 6);
    const int G = gridDim.x; const int bx = blockIdx.x; const int vcu = (G % 8 == 0) ? (bx % 8) * (G / 8) + bx / 8 : bx;
    unsigned char* ws = a.ws;
    volatile LAS unsigned* MISC = (volatile LAS unsigned*)(lds + MISC_OFF);
    if (tid < 32) MISC[tid] = 0u;
    __syncthreads();
    XcdBarrier bar; bar.bar = (unsigned*)(ws + WS_CTL) + CW_BAR; bar.x = 0; bar.st = nullptr;
    const bool multi = (a.ph_hi - a.ph_lo) > 1;
    if (multi) bar = xcd_barrier_post((unsigned*)(ws + WS_CTL) + CW_BAR, MISC + 8);
    const int lo = a.ph_lo, hi = a.ph_hi;
#ifndef PHMASK
#define PHMASK 0xFFFFFFFFu
#endif
#define PHK(j) ((PHMASK >> (j)) & 1u)
#define IN(k) (lo <= (k) && (k) < hi)
#define SEAM(k) do { if (IN(k) && IN((k) + 1)) xcd_barrier(bar); } while (0)

    if (PHK(0) && IN(0)) { p0_prologue(a, lds, vcu, G);
        rowpass<0>(a, lds, vcu, G, a.in[0], nullptr, nullptr, a.in[2], a.in[3], a.in[4], 0); }
    SEAM(0);
#pragma unroll 1
    for (int l = 0; l < 2; ++l) {
        const int pb = 1 + 13 * l;
        const float* xres = (l == 0) ? a.in[0] : a.out;
        if (PHK(1) && IN(pb + 0)) {
            SchedPlain Sz; Sz.TO.init(T / 256, NZ / 256, G, bx); Sz.A = (const char*)(ws + WS_XB); Sz.B = (const char*)(ws + WS_WIN + (size_t)l * NZ * 1024 * 2); Sz.O = (char*)(ws + WS_Z);
            Sz.a_tile = 256 * 1024 * 2; Sz.b_tile = 256 * 1024 * 2; Sz.o_pm = (size_t)256 * NZ * 2; Sz.o_pn = 256 * 2;
            pg8::gemm_phase(lds, pg8::Gemm{1024, 1024, 1024}, Sz, EpiBf16{NZ, 1.f});
            if (l == 0) { __syncthreads(); SchedKV Sk{G, vcu, (const char*)(ws + WS_MEMB), (const char*)(ws + WS_WKV), (char*)(ws + WS_KV)};
                pg8::gemm_phase(lds, pg8::Gemm{1024, 1024, 1024}, Sk, EpiBf16{0, 1.f}); }
        }
        SEAM(pb + 0);
        if (PHK(2) && IN(pb + 1)) p2_pool_state(a, lds, vcu, G, l);
        SEAM(pb + 1);
        if (PHK(3) && IN(pb + 2)) p3_mlstm_out(a, lds, vcu, G, l);
        SEAM(pb + 2);
        if (PHK(4) && IN(pb + 3)) {
            SchedPlain Sp; Sp.TO.init(T / 256, 4, G, bx); Sp.A = (const char*)(ws + WS_MIXED); Sp.B = (const char*)(ws + WS_WOUT + (size_t)l * 2 * MiB); Sp.O = nullptr;
            Sp.a_tile = 256 * 1024 * 2; Sp.b_tile = 256 * 1024 * 2; Sp.o_pm = 0; Sp.o_pn = 0;
            pg8::gemm_phase(lds, pg8::Gemm{1024, 1024, 1024}, Sp, EpiRes{xres, (float*)(ws + WS_Y)});
        }
        SEAM(pb + 3);
        if (PHK(5) && IN(pb + 4)) rowpass<1>(a, lds, vcu, G, (const float*)(ws + WS_Y), a.in[10] + l * D, a.in[11] + l * D, nullptr, nullptr, nullptr, l);
        SEAM(pb + 4);
        if (PHK(6) && IN(pb + 5)) {
            SchedPlain Sp; Sp.TO.init(T / 256, 4, G, bx); Sp.A = (const char*)(ws + WS_XB); Sp.B = (const char*)(ws + WS_WQ + (size_t)l * 2 * MiB); Sp.O = (char*)(ws + WS_Q);
            Sp.a_tile = 256 * 1024 * 2; Sp.b_tile = 256 * 1024 * 2; Sp.o_pm = 256 * 1024 * 2; Sp.o_pn = 256 * 2;
            pg8::gemm_phase(lds, pg8::Gemm{1024, 1024, 1024}, Sp, EpiBf16{1024, 0.0625f});
        }
        SEAM(pb + 5);
        if (PHK(7) && IN(pb + 6)) {
            char* pscr = (char*)(ws + WS_PSCR) + (size_t)bx * 131072;
            const char* Kb = (const char*)(ws + WS_KV + (size_t)l * 16 * MiB); const char* VTb = Kb + 8 * MiB;
            for (int L = vcu; L < 512; L += G) {
                const int b = L >> 5, h = (L >> 3) & 3, qt = L & 7;
                SchedOne S1; S1.u.a = (const char*)(ws + WS_Q) + ((size_t)(b * S + qt * 256) * 1024 + h * 256) * 2; S1.u.b = Kb + ((size_t)(b * 256) * 1024 + h * 256) * 2; S1.u.o = pscr; S1.u.aux = 0; S1.u.aux2 = 0;
                pg8::gemm_phase(lds, pg8::Gemm{1024, 1024, 256}, S1, EpiSoftmax{});
                VM_WAIT(); __syncthreads();
                if (tid == 0) { __builtin_amdgcn_fence(__ATOMIC_ACQUIRE, "agent"); VM_WAIT(); }
                __syncthreads();
                SchedOne S2; S2.u.a = pscr; S2.u.b = VTb + ((size_t)b * 1024 * 256 + (size_t)h * 256 * 256) * 2; S2.u.o = (char*)(ws + WS_O) + ((size_t)(b * S + qt * 256) * 1024 + h * 256) * 2; S2.u.aux = 0; S2.u.aux2 = 0;
                pg8::gemm_phase(lds, pg8::Gemm{256, 256, 256}, S2, EpiBf16{1024, 1.f});
                __syncthreads();
            }
        }
        SEAM(pb + 6);
        if (PHK(8) && IN(pb + 7)) {
            SchedPlain Sp; Sp.TO.init(T / 256, 4, G, bx); Sp.A = (const char*)(ws + WS_O); Sp.B = (const char*)(ws + WS_WO + (size_t)l * 2 * MiB); Sp.O = nullptr;
            Sp.a_tile = 256 * 1024 * 2; Sp.b_tile = 256 * 1024 * 2; Sp.o_pm = 0; Sp.o_pn = 0;
            pg8::gemm_phase(lds, pg8::Gemm{1024, 1024, 1024}, Sp, EpiRes{a.out, (float*)(ws + WS_Y)});
        }
        SEAM(pb + 7);
        if (PHK(9) && IN(pb + 8)) rowpass<2>(a, lds, vcu, G, (const float*)(ws + WS_Y), a.in[15] + l * D, a.in[16] + l * D, nullptr, nullptr, nullptr, l);
        SEAM(pb + 8);
        if (PHK(10) && IN(pb + 9)) p10a_gather(a, lds, vcu, G, l);
        SEAM(pb + 9);
        if (PHK(11) && IN(pb + 10)) {
            SchedMoe<2> Sm; Sm.init((const unsigned*)(ws + WS_CTL) + CW_CNT + l * 16 * 64, G, vcu);
            Sm.A = (const char*)(ws + WS_XG); Sm.a_tile = 256 * 1024 * 2; Sm.W = (const char*)(ws + WS_WGU + (size_t)l * 16 * MiB); Sm.w_exp = 512 * 1024 * 2; Sm.w_pn = 256 * 1024 * 2;
            Sm.O = (char*)(ws + WS_H); Sm.o_tile = 256 * 256 * 2; Sm.o_pn = 128 * 2;
            pg8::gemm_phase(lds, pg8::Gemm{1024, 1024, 1024}, Sm, EpiSiluMul{});
        }
        SEAM(pb + 10);
        if (PHK(12) && IN(pb + 11)) {
            SchedMoe<4> Sm; Sm.init((const unsigned*)(ws + WS_CTL) + CW_CNT + l * 16 * 64, G, vcu);
            Sm.A = (const char*)(ws + WS_H); Sm.a_tile = 256 * 256 * 2; Sm.W = (const char*)(ws + WS_WD + (size_t)l * 8 * MiB); Sm.w_exp = 1024 * 256 * 2; Sm.w_pn = 256 * 256 * 2;
            Sm.O = (char*)(ws + WS_YB); Sm.o_tile = 256 * 1024 * 2; Sm.o_pn = 256 * 2;
            pg8::gemm_phase(lds, pg8::Gemm{256, 256, 256}, Sm, EpiMoeDown{(const float*)(ws + WS_GATEG)});
        }
        SEAM(pb + 11);
        if (PHK(13) && IN(pb + 12)) {
            if (l == 0) rowpass<3>(a, lds, vcu, G, nullptr, a.in[22] + l * D, a.in[23] + l * D, a.in[2] + (size_t)1 * D * NIN, a.in[3] + 4, a.in[4] + 4, l);
            else rowpass<3>(a, lds, vcu, G, nullptr, a.in[22] + l * D, a.in[23] + l * D, nullptr, nullptr, nullptr, l);
        }
        SEAM(pb + 12);
    }
#undef IN
#undef SEAM
}
constexpr int NPHASES = 27;
}
#ifndef KMODE
#define KMODE 1
#endif
static int fast_grid() {
    static int grid = 0;
    if (grid == 0) {
        int dev = 0, cus = 0, per_cu = 0;
        if (hipGetDevice(&dev) != hipSuccess || hipDeviceGetAttribute(&cus, hipDeviceAttributeMultiprocessorCount, dev) != hipSuccess) { fprintf(stderr, "kernel_launch: device query failed\n"); grid = -1; return grid; }
        if (hipFuncSetAttribute((const void*)fk::mk_fwd, hipFuncAttributeMaxDynamicSharedMemorySize, fk::LDS_BYTES) != hipSuccess) { fprintf(stderr, "kernel_launch: hipFuncSetAttribute failed\n"); grid = -1; return grid; }
        if (hipOccupancyMaxActiveBlocksPerMultiprocessor(&per_cu, (const void*)fk::mk_fwd, fk::NTHR, fk::LDS_BYTES) != hipSuccess || per_cu < 1) { fprintf(stderr, "kernel_launch: occupancy query says %d blocks/CU\n", per_cu); (void)hipGetLastError(); grid = -1; return grid; }
        grid = cus;
        if (grid > 256) grid = 256;
        if (grid % 8) grid -= grid % 8;
    }
    return grid;
}
static void fast_launch(hipStream_t st, const fk::Args& a0, int lo, int hi) {
    const int grid = fast_grid(); if (grid <= 0) return;
    fk::Args a = a0; a.ph_lo = lo; a.ph_hi = hi;
    hipLaunchKernelGGL(fk::mk_fwd, dim3(grid), dim3(fk::NTHR), fk::LDS_BYTES, st, a);
    const hipError_t le = hipPeekAtLastError();
    if (le != hipSuccess) fprintf(stderr, "kernel_launch: launch [%d,%d) failed: %s\n", lo, hi, hipGetErrorName(le));
}
extern "C" void kernel_launch(void* const* d_in, const int* in_sizes, int n_in, void* d_out, int out_size, void* d_ws, size_t ws_size, hipStream_t stream) {
    if (n_in != 24 || out_size != slow::T * slow::D || ws_size < (size_t)501 * (1u << 20)) { fprintf(stderr, "kernel_launch: unexpected shapes n_in=%d out=%d ws=%zu\n", n_in, out_size, ws_size); return; }
    fk::Args a{};
    for (int i = 0; i < 24; ++i) a.in[i] = (const float*)d_in[i];
    a.out = (float*)d_out; a.ws = (unsigned char*)d_ws;
#if KMODE == 0
    slow::forward(stream, d_in, (float*)d_out, d_ws);
#elif KMODE == 1
    (void)hipMemsetAsync((char*)d_ws + fk::WS_CTL, 0, fk::CTL_BYTES, stream);
    fast_launch(stream, a, 0, fk::NPHASES);
#elif KMODE == 2
    (void)hipMemsetAsync((char*)d_ws + fk::WS_CTL, 0, fk::CTL_BYTES, stream);
    for (int p = 0; p < fk::NPHASES; ++p) fast_launch(stream, a, p, p + 1);
#else
    HYBRID_SEQUENCE
#endif
}
```

```cpp
#include <hip/hip_runtime.h>
#include <cstdio>
#include <cstdint>
#define KMODE 1
namespace slow {

constexpr int T = 32768, D = 1024, S = 2048, NB = 16, NIN = 2568;

__global__ void __launch_bounds__(256) sgemm_k(const float* __restrict__ A, int lda, const float* __restrict__ B, int ldb,
                                               float* __restrict__ C, int ldc, int M, int N, int K) {
    __shared__ float sA[16][64 + 4];
    __shared__ float sB[16][64 + 4];
    const int tid = threadIdx.x, tx = tid & 15, ty = tid >> 4;
    const int m0 = blockIdx.y * 64, n0 = blockIdx.x * 64;
    float acc[4][4];
#pragma unroll
    for (int i = 0; i < 4; ++i)
#pragma unroll
        for (int j = 0; j < 4; ++j) acc[i][j] = 0.f;
    for (int k0 = 0; k0 < K; k0 += 16) {
#pragma unroll
        for (int i = 0; i < 4; ++i) { const int e = tid + i * 256; const int r = e >> 4, c = e & 15; sA[c][r] = A[(size_t)(m0 + r) * lda + k0 + c]; }
#pragma unroll
        for (int i = 0; i < 4; ++i) { const int e = tid + i * 256; const int r = e >> 6, c = e & 63; sB[r][c] = (n0 + c < N) ? B[(size_t)(k0 + r) * ldb + n0 + c] : 0.f; }
        __syncthreads();
#pragma unroll
        for (int k = 0; k < 16; ++k) {
            float a[4], b[4];
#pragma unroll
            for (int i = 0; i < 4; ++i) a[i] = sA[k][ty * 4 + i];
#pragma unroll
            for (int j = 0; j < 4; ++j) b[j] = sB[k][tx * 4 + j];
#pragma unroll
            for (int i = 0; i < 4; ++i)
#pragma unroll
                for (int j = 0; j < 4; ++j) acc[i][j] = fmaf(a[i], b[j], acc[i][j]);
        }
        __syncthreads();
    }
#pragma unroll
    for (int i = 0; i < 4; ++i)
#pragma unroll
        for (int j = 0; j < 4; ++j) { const int n = n0 + tx * 4 + j; if (n < N) C[(size_t)(m0 + ty * 4 + i) * ldc + n] = acc[i][j]; }
}

__device__ __forceinline__ float sigmoidf_(float x) { return 1.f / (1.f + expf(-x)); }
__device__ __forceinline__ float siluf_(float x) { return x / (1.f + expf(-x)); }
__device__ __forceinline__ float logsigmoidf_(float x) { return fminf(x, 0.f) - log1pf(expf(-fabsf(x))); }

__global__ void gates_k(const float* __restrict__ Z, const float* __restrict__ b_i, const float* __restrict__ b_f, float* __restrict__ BC, float* __restrict__ IG) {
    const int id = blockIdx.x * blockDim.x + threadIdx.x; if (id >= NB * 4) return;
    const int b = id >> 2, h = id & 3; float c = 0.f;
    for (int t = 0; t < S; ++t) {
        const float* z = Z + (size_t)(b * S + t) * NIN;
        c += logsigmoidf_(z[2052 + h] + b_f[h]);
        BC[(size_t)id * S + t] = c; IG[(size_t)id * S + t] = z[2048 + h] + b_i[h];
    }
}
__global__ void conv_k(float* __restrict__ Z, const float* __restrict__ w  ) {
    const int id = blockIdx.x * blockDim.x + threadIdx.x; if (id >= NB * 1024) return;
    const int b = id >> 10, c = id & 1023;
    const float w0 = w[c], w1 = w[1024 + c], w2 = w[2048 + c], w3 = w[3072 + c];
    float* z = Z + (size_t)b * S * NIN + c;
    for (int t = S - 1; t >= 0; --t) {
        const float u3 = z[(size_t)t * NIN], u2 = t >= 1 ? z[(size_t)(t - 1) * NIN] : 0.f, u1 = t >= 2 ? z[(size_t)(t - 2) * NIN] : 0.f, u0 = t >= 3 ? z[(size_t)(t - 3) * NIN] : 0.f;
        z[(size_t)t * NIN] = siluf_(w0 * u0 + w1 * u1 + w2 * u2 + w3 * u3);
    }
}
__global__ void __launch_bounds__(128) mlstm_k(const float* __restrict__ Z, const float* __restrict__ BC, const float* __restrict__ IG,
                                               const float* __restrict__ hng  , float* __restrict__ MIXED) {
    const int t = blockIdx.x, h = blockIdx.y, b = blockIdx.z, j = threadIdx.x;
    __shared__ float sq[128]; __shared__ float sp[128]; __shared__ float red[4];
    const float* zb = Z + (size_t)b * S * NIN;
    sq[j] = zb[(size_t)t * NIN + h * 128 + j] * 0.08838834764831845f;
    const float* bc = BC + (size_t)(b * 4 + h) * S; const float* ig = IG + (size_t)(b * 4 + h) * S;
    const float Bt = bc[t];
    __syncthreads();
    float num = 0.f, den = 0.f;
    for (int s0 = 0; s0 <= t; s0 += 128) {
        const int s = s0 + j; float p = 0.f;
        if (s <= t) {
            const float4* kr = (const float4*)(zb + (size_t)s * NIN + 512 + h * 128); float dot = 0.f;
#pragma unroll 8
            for (int d = 0; d < 32; ++d) { const float4 kv = kr[d]; dot += sq[4 * d] * kv.x + sq[4 * d + 1] * kv.y + sq[4 * d + 2] * kv.z + sq[4 * d + 3] * kv.w; }
            p = expf(Bt - bc[s] + ig[s]) * dot;
        }
        sp[j] = p;
        __syncthreads();
        const int cnt = min(128, t - s0 + 1);
        for (int jj = 0; jj < cnt; ++jj) { const float pp = sp[jj]; num = fmaf(pp, zb[(size_t)(s0 + jj) * NIN + 1024 + h * 128 + j], num); den += pp; }
        __syncthreads();
    }
    float hv = num / fmaxf(fabsf(den), 1.f);
    float sum = hv;
#pragma unroll
    for (int o = 32; o > 0; o >>= 1) sum += __shfl_xor(sum, o);
    if ((j & 63) == 0) red[j >> 6] = sum;
    __syncthreads();
    const float mu = (red[0] + red[1]) * (1.f / 128.f);
    const float dv = hv - mu; float sq2 = dv * dv;
#pragma unroll
    for (int o = 32; o > 0; o >>= 1) sq2 += __shfl_xor(sq2, o);
    if ((j & 63) == 0) red[2 + (j >> 6)] = sq2;
    __syncthreads();
    const float var = (red[2] + red[3]) * (1.f / 128.f);
    const float hn = dv * rsqrtf(var + 1e-5f) * hng[h * 128 + j];
    const float og = sigmoidf_(zb[(size_t)t * NIN + 1536 + h * 128 + j]);
    MIXED[(size_t)(b * S + t) * 1024 + h * 128 + j] = hn * og;
}
__global__ void __launch_bounds__(512) pool_k(const float* __restrict__ Z, const float* __restrict__ pw  , const float* __restrict__ ps  , float* __restrict__ MIXED) {
    const int row = blockIdx.x, t = row & (S - 1), tid = threadIdx.x, g = tid >> 7, d = tid & 127;
    __shared__ float pl[512];
    const int w = 2 << g;
    float sum = 0.f;
    for (int r = 0; r < w; ++r) if (t - r >= 0) sum += Z[(size_t)(row - r) * NIN + 2056 + tid];
    pl[tid] = sum / (float)min(t + 1, w) - Z[(size_t)row * NIN + 2056 + tid];
    __syncthreads();
    float acc = 0.f;
    for (int c = 0; c < 128; ++c) acc = fmaf(pl[g * 128 + c], pw[(size_t)(g * 128 + c) * 128 + d], acc);
    MIXED[(size_t)row * 1024 + 512 + tid] = acc * ps[tid];
}
__global__ void __launch_bounds__(256) ln_k(float* __restrict__ X, const float* __restrict__ Y, const float* __restrict__ g, const float* __restrict__ bb) {
    const int row = blockIdx.x, tid = threadIdx.x; __shared__ float red[8];
    float4 x = ((const float4*)(X + (size_t)row * 1024))[tid]; const float4 y = ((const float4*)(Y + (size_t)row * 1024))[tid];
    const float al = 1.4142135623730951f;
    x.x = al * x.x + y.x; x.y = al * x.y + y.y; x.z = al * x.z + y.z; x.w = al * x.w + y.w;
    float s = (x.x + x.y) + (x.z + x.w);
#pragma unroll
    for (int o = 32; o > 0; o >>= 1) s += __shfl_xor(s, o);
    if ((tid & 63) == 0) red[tid >> 6] = s;
    __syncthreads();
    const float mu = (red[0] + red[1] + red[2] + red[3]) * (1.f / 1024.f);
    x.x -= mu; x.y -= mu; x.z -= mu; x.w -= mu;
    float q = (x.x * x.x + x.y * x.y) + (x.z * x.z + x.w * x.w);
#pragma unroll
    for (int o = 32; o > 0; o >>= 1) q += __shfl_xor(q, o);
    if ((tid & 63) == 0) red[4 + (tid >> 6)] = q;
    __syncthreads();
    const float rs = rsqrtf((red[4] + red[5] + red[6] + red[7]) * (1.f / 1024.f) + 1e-5f);
    const float4 gg = ((const float4*)g)[tid], b4 = ((const float4*)bb)[tid];
    float4 o; o.x = x.x * rs * gg.x + b4.x; o.y = x.y * rs * gg.y + b4.y; o.z = x.z * rs * gg.z + b4.z; o.w = x.w * rs * gg.w + b4.w;
    ((float4*)(X + (size_t)row * 1024))[tid] = o;
}
__global__ void __launch_bounds__(256) xattn_k(const float* __restrict__ Q, const float* __restrict__ KV, float* __restrict__ O) {
    const int row = blockIdx.x, h = blockIdx.y, b = row / S, tid = threadIdx.x;
    __shared__ float sq[256]; __shared__ float sp[256]; __shared__ float red[8];
    sq[tid] = Q[(size_t)row * 1024 + h * 256 + tid];
    __syncthreads();
    const float4* kr = (const float4*)(KV + (size_t)(b * 256 + tid) * 2048 + h * 256); float dot = 0.f;
#pragma unroll 8
    for (int d = 0; d < 64; ++d) { const float4 kv = kr[d]; dot += sq[4 * d] * kv.x + sq[4 * d + 1] * kv.y + sq[4 * d + 2] * kv.z + sq[4 * d + 3] * kv.w; }
    dot *= 0.0625f;
    float m = dot;
#pragma unroll
    for (int o = 32; o > 0; o >>= 1) m = fmaxf(m, __shfl_xor(m, o));
    if ((tid & 63) == 0) red[tid >> 6] = m;
    __syncthreads();
    m = fmaxf(fmaxf(red[0], red[1]), fmaxf(red[2], red[3]));
    const float e = expf(dot - m); float s = e;
#pragma unroll
    for (int o = 32; o > 0; o >>= 1) s += __shfl_xor(s, o);
    if ((tid & 63) == 0) red[4 + (tid >> 6)] = s;
    sp[tid] = e;
    __syncthreads();
    const float inv = 1.f / (red[4] + red[5] + red[6] + red[7]);
    float acc = 0.f;
    for (int mm = 0; mm < 256; ++mm) acc = fmaf(sp[mm], KV[(size_t)(b * 256 + mm) * 2048 + 1024 + h * 256 + tid], acc);
    O[(size_t)row * 1024 + h * 256 + tid] = acc * inv;
}
__global__ void __launch_bounds__(64) router_k(const float* __restrict__ X, const float* __restrict__ rw  , const float* __restrict__ rb, int* __restrict__ EI, float* __restrict__ GT) {
    const int row = blockIdx.x, lane = threadIdx.x;
    float acc[16];
#pragma unroll
    for (int e = 0; e < 16; ++e) acc[e] = 0.f;
    for (int i = 0; i < 16; ++i) { const int d = lane + 64 * i; const float xv = X[(size_t)row * 1024 + d]; const float4* r4 = (const float4*)(rw + (size_t)d * 16);
#pragma unroll
        for (int q = 0; q < 4; ++q) { const float4 r = r4[q]; acc[4 * q] = fmaf(xv, r.x, acc[4 * q]); acc[4 * q + 1] = fmaf(xv, r.y, acc[4 * q + 1]); acc[4 * q + 2] = fmaf(xv, r.z, acc[4 * q + 2]); acc[4 * q + 3] = fmaf(xv, r.w, acc[4 * q + 3]); } }
#pragma unroll
    for (int e = 0; e < 16; ++e) {
#pragma unroll
        for (int o = 32; o > 0; o >>= 1) acc[e] += __shfl_xor(acc[e], o);
    }
    if (lane == 0) {
        float sc[16], sel[16];
#pragma unroll
        for (int e = 0; e < 16; ++e) { sc[e] = sigmoidf_(acc[e]); sel[e] = sc[e] + rb[e]; }
        int best = 0; float bestv = -1e30f;
#pragma unroll
        for (int g = 0; g < 4; ++g) {
            float m1 = -1e30f, m2 = -1e30f;
#pragma unroll
            for (int i = 0; i < 4; ++i) { const float v = sel[4 * g + i]; if (v > m1) { m2 = m1; m1 = v; } else if (v > m2) m2 = v; }
            const float gs = m1 + m2; if (gs > bestv) { bestv = gs; best = g; }
        }
        int i1 = 0; float v1 = -1e30f;
#pragma unroll
        for (int i = 0; i < 4; ++i) { const float v = sel[4 * best + i]; if (v > v1) { v1 = v; i1 = i; } }
        int i2 = 0; float v2 = -1e30f;
#pragma unroll
        for (int i = 0; i < 4; ++i) { const float v = sel[4 * best + i]; if (i != i1 && v > v2) { v2 = v; i2 = i; } }
        const int e1 = 4 * best + i1, e2 = 4 * best + i2; const float g1 = sc[e1], g2 = sc[e2], inv = 1.f / (g1 + g2);
        EI[2 * row] = e1; EI[2 * row + 1] = e2; GT[2 * row] = g1 * inv; GT[2 * row + 1] = g2 * inv;
    }
}
__global__ void __launch_bounds__(256) moe_k(const float* __restrict__ X, const int* __restrict__ EI, const float* __restrict__ GT,
                                             const float* __restrict__ wg, const float* __restrict__ wu, const float* __restrict__ wd, float* __restrict__ FF) {
    const int row = blockIdx.x, tid = threadIdx.x; __shared__ float sx[1024]; __shared__ float sh[256];
    for (int i = tid; i < 1024; i += 256) sx[i] = X[(size_t)row * 1024 + i];
    float y[4] = {0.f, 0.f, 0.f, 0.f};
    __syncthreads();
    for (int k = 0; k < 2; ++k) {
        const int e = EI[2 * row + k]; const float gt = GT[2 * row + k];
        const float* g_ = wg + (size_t)e * 1024 * 256 + tid; const float* u_ = wu + (size_t)e * 1024 * 256 + tid;
        float ga = 0.f, ua = 0.f;
        for (int d = 0; d < 1024; ++d) { const float xv = sx[d]; ga = fmaf(xv, g_[(size_t)d * 256], ga); ua = fmaf(xv, u_[(size_t)d * 256], ua); }
        sh[tid] = siluf_(ga) * ua * gt;
        __syncthreads();
        const float* d_ = wd + (size_t)e * 256 * 1024 + tid;
        for (int j = 0; j < 256; ++j) { const float hv = sh[j];
#pragma unroll
            for (int c = 0; c < 4; ++c) y[c] = fmaf(hv, d_[(size_t)j * 1024 + c * 256], y[c]); }
        __syncthreads();
    }
#pragma unroll
    for (int c = 0; c < 4; ++c) FF[(size_t)row * 1024 + c * 256 + tid] = y[c];
}

struct Ws { float *Z, *MIXED, *R0, *R1, *KV, *BC, *IG, *GT; int* EI; };
inline Ws carve(void* d_ws) {
    char* w = (char*)d_ws; const size_t MiB = 1u << 20; Ws s;
    s.Z = (float*)w; s.R0 = (float*)w; s.R1 = (float*)(w + 128 * MiB);
    s.MIXED = (float*)(w + 336 * MiB);
    s.KV = (float*)(w + 465 * MiB); s.BC = (float*)(w + 497 * MiB); s.IG = (float*)(w + 498 * MiB);
    s.GT = (float*)(w + 499 * MiB); s.EI = (int*)(w + 500 * MiB);
    return s;
}
inline void sgemm(hipStream_t st, const float* A, int lda, const float* B, int ldb, float* C, int ldc, int M, int N, int K) {
    hipLaunchKernelGGL(sgemm_k, dim3((N + 63) / 64, M / 64), dim3(256), 0, st, A, lda, B, ldb, C, ldc, M, N, K);
}
inline void mixer(hipStream_t st, void* const* d_in, int l, float* X, const Ws& w) {
    const float* w_in = (const float*)d_in[2] + (size_t)l * D * NIN;
    sgemm(st, X, D, w_in, NIN, w.Z, NIN, T, NIN, D);
    hipLaunchKernelGGL(gates_k, dim3(1), dim3(64), 0, st, w.Z, (const float*)d_in[3] + l * 4, (const float*)d_in[4] + l * 4, w.BC, w.IG);
    hipLaunchKernelGGL(conv_k, dim3(NB * 1024 / 256), dim3(256), 0, st, w.Z, (const float*)d_in[5] + (size_t)l * 4096);
    hipLaunchKernelGGL(mlstm_k, dim3(S, 4, NB), dim3(128), 0, st, w.Z, w.BC, w.IG, (const float*)d_in[6] + l * 512, w.MIXED);
    hipLaunchKernelGGL(pool_k, dim3(T), dim3(512), 0, st, w.Z, (const float*)d_in[7] + (size_t)l * 65536, (const float*)d_in[8] + l * 512, w.MIXED);
    sgemm(st, w.MIXED, D, (const float*)d_in[9] + (size_t)l * D * D, D, w.R0, D, T, D, D);
    hipLaunchKernelGGL(ln_k, dim3(T), dim3(256), 0, st, X, w.R0, (const float*)d_in[10] + l * D, (const float*)d_in[11] + l * D);
}
inline void xattn(hipStream_t st, void* const* d_in, int l, float* X, const Ws& w) {
    sgemm(st, X, D, (const float*)d_in[12] + (size_t)l * D * D, D, w.R0, D, T, D, D);
    sgemm(st, (const float*)d_in[1], D, (const float*)d_in[13] + (size_t)l * D * 2 * D, 2 * D, w.KV, 2 * D, NB * 256, 2 * D, D);
    hipLaunchKernelGGL(xattn_k, dim3(T, 4), dim3(256), 0, st, w.R0, w.KV, w.R1);
    sgemm(st, w.R1, D, (const float*)d_in[14] + (size_t)l * D * D, D, w.R0, D, T, D, D);
    hipLaunchKernelGGL(ln_k, dim3(T), dim3(256), 0, st, X, w.R0, (const float*)d_in[15] + l * D, (const float*)d_in[16] + l * D);
}
inline void moe(hipStream_t st, void* const* d_in, int l, float* X, const Ws& w) {
    hipLaunchKernelGGL(router_k, dim3(T), dim3(64), 0, st, X, (const float*)d_in[17], (const float*)d_in[18], w.EI, w.GT);
    const size_t eo = (size_t)l * 16 * 1024 * 256;
    hipLaunchKernelGGL(moe_k, dim3(T), dim3(256), 0, st, X, w.EI, w.GT, (const float*)d_in[19] + eo, (const float*)d_in[20] + eo, (const float*)d_in[21] + eo, w.R0);
    hipLaunchKernelGGL(ln_k, dim3(T), dim3(256), 0, st, X, w.R0, (const float*)d_in[22] + l * D, (const float*)d_in[23] + l * D);
}
inline void forward(hipStream_t st, void* const* d_in, float* out, void* d_ws) {
    const Ws w = carve(d_ws);
    hipMemcpyAsync(out, d_in[0], (size_t)T * D * 4, hipMemcpyDeviceToDevice, st);
    for (int l = 0; l < 2; ++l) { mixer(st, d_in, l, out, w); xattn(st, d_in, l, out, w); moe(st, d_in, l, out, w); }
}
}
#define GAS __attribute__((address_space(1)))
#define LAS __attribute__((address_space(3)))
typedef unsigned short bf16;
typedef short bf16x8 __attribute__((ext_vector_type(8)));
typedef float f32x4 __attribute__((ext_vector_type(4)));
typedef float f32x2 __attribute__((ext_vector_type(2)));
typedef unsigned u32x4 __attribute__((ext_vector_type(4)));
typedef unsigned u32x2 __attribute__((ext_vector_type(2)));
#define RLX_AGENT __ATOMIC_RELAXED, __HIP_MEMORY_SCOPE_AGENT
#define LDS_WAIT() asm volatile("s_waitcnt lgkmcnt(0)" ::: "memory")
#define VM_WAIT() asm volatile("s_waitcnt vmcnt(0)" ::: "memory")

__device__ __forceinline__ unsigned f2bf(float f) { unsigned u = __builtin_bit_cast(unsigned, f); return (u + 0x7fffu + ((u >> 16) & 1u)) >> 16; }
__device__ __forceinline__ unsigned pk2(float lo, float hi) { unsigned r; asm volatile("v_cvt_pk_bf16_f32 %0, %1, %2" : "=v"(r) : "v"(lo), "v"(hi)); return r; }
__device__ __forceinline__ float bf2f(unsigned short h) { return __builtin_bit_cast(float, (unsigned)h << 16); }
__device__ __forceinline__ float bflo(unsigned w) { return __builtin_bit_cast(float, w << 16); }
__device__ __forceinline__ float bfhi(unsigned w) { return __builtin_bit_cast(float, w & 0xffff0000u); }
__device__ __forceinline__ float sigm(float x) { return 1.f / (1.f + __expf(-x)); }
__device__ __forceinline__ float silu(float x) { return x / (1.f + __expf(-x)); }
__device__ __forceinline__ float logsig(float x) { return fminf(x, 0.f) - log1pf(__expf(-fabsf(x))); }
#define DPP_F(v, ctrl) __builtin_bit_cast(float, __builtin_amdgcn_update_dpp(__builtin_bit_cast(int, (v)), __builtin_bit_cast(int, (v)), (ctrl), 0xf, 0xf, true))
#define DPP_XOR1 0xB1
#define DPP_XOR2 0x4E
#define DPP_HMIRROR 0x141
#define DPP_MIRROR 0x140
#define DPP_BCAST15 0x142
#define DPP_BCAST31 0x143
__device__ __forceinline__ float red_x1(float v) { return DPP_F(v, DPP_XOR1); }
__device__ __forceinline__ float red_x2(float v) { return DPP_F(v, DPP_XOR2); }
__device__ __forceinline__ float red_x4(float v) { return DPP_F(v, DPP_HMIRROR); }
__device__ __forceinline__ float red_x8(float v) { return DPP_F(v, DPP_MIRROR); }
__device__ __forceinline__ float wave_sum(float v) {
    v += red_x1(v); v += red_x2(v); v += red_x4(v); v += red_x8(v);
    v += __builtin_bit_cast(float, __builtin_amdgcn_update_dpp(0, __builtin_bit_cast(int, v), DPP_BCAST15, 0xa, 0xf, false));
    v += __builtin_bit_cast(float, __builtin_amdgcn_update_dpp(0, __builtin_bit_cast(int, v), DPP_BCAST31, 0xc, 0xf, false));
    return __builtin_bit_cast(float, __builtin_amdgcn_readlane(__builtin_bit_cast(int, v), 63));
}
__device__ __forceinline__ float wave_max(float v) {
    v = fmaxf(v, red_x1(v)); v = fmaxf(v, red_x2(v)); v = fmaxf(v, red_x4(v)); v = fmaxf(v, red_x8(v));
    const int ninf = __builtin_bit_cast(int, -3.0e38f);
    v = fmaxf(v, __builtin_bit_cast(float, __builtin_amdgcn_update_dpp(ninf, __builtin_bit_cast(int, v), DPP_BCAST15, 0xa, 0xf, false)));
    v = fmaxf(v, __builtin_bit_cast(float, __builtin_amdgcn_update_dpp(ninf, __builtin_bit_cast(int, v), DPP_BCAST31, 0xc, 0xf, false)));
    return __builtin_bit_cast(float, __builtin_amdgcn_readlane(__builtin_bit_cast(int, v), 63));
}
__device__ __forceinline__ float group8_sum(float v) { v += red_x1(v); v += red_x2(v); v += red_x4(v); return v; }
template <int N> __device__ __forceinline__ void allreduce_vec(const float (&p)[N], float (&out)[N], int lane) {
#pragma unroll
    for (int e = 0; e < N; ++e) out[e] = wave_sum(p[e]);
}

#define XB_TMO      128
#define XB_XCNT(j)  (256  + 64 * (j))
#define XB_XSUB(j)  (1280 + 64 * (j))
#define XB_XGEN(j)  (2304 + 64 * (j))
#define XB_TOP      3328
#define XB_TOPGEN   3392
#define XCD_BAR_WORDS 3456
#define XB_SPIN_CAP (1u << 18)
__device__ __forceinline__ unsigned xb_ld(unsigned* p)              { return __hip_atomic_load(p, __ATOMIC_RELAXED, __HIP_MEMORY_SCOPE_AGENT); }
__device__ __forceinline__ unsigned xb_add(unsigned* p, unsigned v) { return __hip_atomic_fetch_add(p, v, __ATOMIC_RELAXED, __HIP_MEMORY_SCOPE_AGENT); }
__device__ __forceinline__ unsigned xb_xcc_id() { return (unsigned)__builtin_amdgcn_s_getreg((3 << 11) | 20) & 0xFu; }
#define XB_SPIN(cond, bar) do { unsigned _sp = 0; while (cond) { __builtin_amdgcn_s_sleep(1); \
    if ((++_sp & 255u) == 0u) { if (xb_ld(&(bar)[XB_TMO])) break; if (_sp > XB_SPIN_CAP) { atomicAdd(&(bar)[XB_TMO], 1u); break; } } } } while (0)
struct XcdBarrier { unsigned* bar; unsigned x; volatile LAS unsigned* st; };
__device__ __forceinline__ XcdBarrier xcd_barrier_post(unsigned* bar, volatile LAS unsigned* st) {
    XcdBarrier b; b.bar = bar; b.x = xb_xcc_id(); b.st = st;
    if (threadIdx.x == 0) (void)xb_add(&bar[XB_XCNT(b.x)], 1u);
    return b;
}
__device__ __forceinline__ void xcd_barrier_complete(unsigned* bar, unsigned x, unsigned& nloc, unsigned& nx) {
    const unsigned G = gridDim.x * gridDim.y * gridDim.z;
    unsigned sum, cnt, mine, sp = 0u;
    for (;;) {
        sum = 0u; cnt = 0u; mine = 0u;
#pragma unroll
        for (unsigned j = 0; j < 16; ++j) { const unsigned c = xb_ld(&bar[XB_XCNT(j)]); sum += c; cnt += (c > 0u) ? 1u : 0u; mine = (j == x) ? c : mine; }
        if (sum == G) break;
        __builtin_amdgcn_s_sleep(1);
        if ((++sp & 255u) == 0u) { if (xb_ld(&bar[XB_TMO])) break; if (sp > XB_SPIN_CAP) { atomicAdd(&bar[XB_TMO], 1u); break; } }
    }
    nloc = mine > 0u ? mine : 1u; nx = cnt > 0u ? cnt : 1u;
}
__device__ __forceinline__ void xcd_barrier(const XcdBarrier& b) {
    asm volatile("s_waitcnt vmcnt(0)" ::: "memory");
    __syncthreads();
    if (threadIdx.x == 0) {
        unsigned* bar = b.bar;
        __builtin_amdgcn_s_waitcnt(0);
        unsigned nloc = b.st[0], nx = b.st[1];
        if (nloc == 0u) { xcd_barrier_complete(bar, b.x, nloc, nx); b.st[0] = nloc; b.st[1] = nx; }
        const unsigned old = xb_add(&bar[XB_XSUB(b.x)], 1u);
        const unsigned gen = old / nloc;
        if (old + 1u == (gen + 1u) * nloc) {
            __builtin_amdgcn_fence(__ATOMIC_RELEASE, "agent");
            asm volatile("s_waitcnt vmcnt(0)" ::: "memory");
            const unsigned og = xb_add(&bar[XB_TOP], 1u);
            const unsigned tg = og / nx;
            if (og + 1u == (tg + 1u) * nx) xb_add(&bar[XB_TOPGEN], 1u);
            else XB_SPIN(xb_ld(&bar[XB_TOPGEN]) == tg, bar);
            __builtin_amdgcn_fence(__ATOMIC_ACQUIRE, "agent");
            xb_add(&bar[XB_XGEN(b.x)], 1u);
            asm volatile("s_waitcnt vmcnt(0)" ::: "memory");
        } else {
            XB_SPIN(xb_ld(&bar[XB_XGEN(b.x)]) == gen, bar);
            __builtin_amdgcn_fence(__ATOMIC_ACQUIRE, "agent");
            asm volatile("s_waitcnt vmcnt(0)" ::: "memory");
        }
    }
    __syncthreads();
}

namespace pg8 {
constexpr int BM = 256, BK = 64, HALF = 128, HTB = HALF * BK * 2, STAGE_BYTES = 8 * HTB;
__host__ __device__ __forceinline__ int lds_byte(int r, int c) { const int st = (r >> 4) * 2 + (c >> 5), rr = r & 15, cc = c & 31, ob = rr * 64 + cc * 2; return st * 1024 + (ob ^ (((ob >> 9) & 1) << 5)); }
__host__ __device__ __forceinline__ void stage_rc(int b, int& R, int& C) { const int st = b / 1024, sb = b % 1024, swz = sb ^ (((sb >> 9) & 1) << 5); R = (st >> 1) * 16 + swz / 64; C = (st & 1) * 32 + (swz % 64) / 2; }
__host__ __device__ __forceinline__ int perm32(int rho) { const int n = rho >> 4, i = rho & 15; return 8 * (i >> 2) + 4 * n + (i & 3); }

struct Unit { const char* a; const char* b; void* o; int aux, aux2; };
struct Gemm { int lda, ldb, K; };

template <class Epi, class Sched>
__device__ __forceinline__ void gemm_phase(LAS unsigned char* lds, const Gemm g, const Sched& S, const Epi& E) {
    int tid_ = threadIdx.x; asm volatile("" : "+v"(tid_));
    const int tid = tid_, wid = __builtin_amdgcn_readfirstlane(tid >> 6), lane = tid & 63, wr = wid >> 2, wc = wid & 3, fr = lane & 15, fq = lane >> 4;
    const int K = g.K, nt = K / BK;
    unsigned voffA[2], voffB[2];
#pragma unroll
    for (int i = 0; i < 2; ++i) { int R, C; stage_rc(tid * 16 + i * 8192, R, C); const int Rb = Epi::PERM ? ((R & ~31) + perm32(R & 31)) : R;
        voffA[i] = (unsigned)(R * g.lda + C) * 2u; voffB[i] = (unsigned)(Rb * g.ldb + C) * 2u; }
    const size_t kstep = (size_t)(BK * 2);
    const size_t hstepA = (size_t)HALF * g.lda * 2, hstepB = (size_t)HALF * g.ldb * 2;
    const unsigned ldsw = (unsigned)wid * 1024u;
    const int aoff = lds_byte(wr * 64 + fr, fq * 8), boff = lds_byte(wc * 32 + fr, fq * 8);
#define PG8_SA(b, h) (((b) * 2 + (h)) * HTB)
#define PG8_SB(b, h) ((4 + (b) * 2 + (h)) * HTB)
#define PG8_STAGE(bufoff, gbase, voff) do { _Pragma("unroll") for (int _i = 0; _i < 2; ++_i) \
        __builtin_amdgcn_global_load_lds((const unsigned*)((const char*)(gbase) + (voff)[_i]), (LAS unsigned*)(lds + (bufoff) + ldsw + _i * 8192), 16, 0, 0); } while (0)
#define PG8_LDA(dst, b, h) do { _Pragma("unroll") for (int m = 0; m < 4; ++m) _Pragma("unroll") for (int k = 0; k < 2; ++k) dst[m][k] = *(const LAS bf16x8*)(lds + PG8_SA(b, h) + aoff + m * 2048 + k * 1024); } while (0)
#define PG8_LDB(dst, b, h) do { _Pragma("unroll") for (int n = 0; n < 2; ++n) _Pragma("unroll") for (int k = 0; k < 2; ++k) dst[n][k] = *(const LAS bf16x8*)(lds + PG8_SB(b, h) + boff + n * 2048 + k * 1024); } while (0)
#define PG8_MMA(ai, bj, At, Bt) do { __builtin_amdgcn_s_setprio(1); _Pragma("unroll") for (int m = 0; m < 4; ++m) _Pragma("unroll") for (int n = 0; n < 2; ++n) _Pragma("unroll") for (int k = 0; k < 2; ++k) \
        acc[ai][bj][m][n] = __builtin_amdgcn_mfma_f32_16x16x32_bf16(Bt[n][k], At[m][k], acc[ai][bj][m][n], 0, 0, 0); __builtin_amdgcn_s_setprio(0); } while (0)
#define PG8_WAIT_V(n) asm volatile("s_waitcnt vmcnt(" #n ")" ::: "memory")
#define PG8_WAIT_L(n) asm volatile("s_waitcnt lgkmcnt(" #n ")" ::: "memory")
#define PG8_BAR __builtin_amdgcn_s_barrier()
#define PG8_SCHED __builtin_amdgcn_sched_barrier(0)
    Unit cur, nxt; int ui = 0;
    if (!S.next(0, cur)) return;
    f32x4 acc[2][2][4][2];
#pragma unroll
    for (int a = 0; a < 2; ++a)
#pragma unroll
        for (int b = 0; b < 2; ++b)
#pragma unroll
            for (int m = 0; m < 4; ++m)
#pragma unroll
                for (int n = 0; n < 2; ++n) acc[a][b][m][n] = (f32x4){0.f, 0.f, 0.f, 0.f};
    bf16x8 At[4][2], B0[2][2], B1[2][2];
    const char* cA = cur.a; const char* cB = cur.b;
    PG8_STAGE(PG8_SB(0, 0), cB, voffB); PG8_STAGE(PG8_SB(0, 1), cB + hstepB, voffB); PG8_STAGE(PG8_SA(0, 0), cA, voffA); PG8_STAGE(PG8_SA(0, 1), cA + hstepA, voffA);
    if (wr == 1) PG8_BAR;
    PG8_WAIT_V(2); PG8_BAR;
    PG8_STAGE(PG8_SB(1, 0), cB + kstep, voffB); PG8_STAGE(PG8_SA(1, 0), cA + kstep, voffA); PG8_STAGE(PG8_SB(1, 1), cB + hstepB + kstep, voffB);
    PG8_WAIT_V(6); PG8_BAR;
    for (;;) {
        const bool has_next = S.next(ui + 1, nxt);
        const char* nA = has_next ? nxt.a : cA; const char* nB = has_next ? nxt.b : cB;
#pragma unroll 1
        for (int t = 0; t < nt; t += 2) {
            const bool last = (t == nt - 2);
            const char* a1 = cA + (size_t)(t + 1) * kstep;
            const char* a2 = last ? nA : cA + (size_t)(t + 2) * kstep; const char* b2 = last ? nB : cB + (size_t)(t + 2) * kstep;
            const char* a3 = a2 + kstep; const char* b3 = b2 + kstep;
            PG8_LDB(B0, 0, 0); PG8_LDB(B1, 0, 1); PG8_SCHED; PG8_LDA(At, 0, 0); PG8_STAGE(PG8_SA(1, 1), a1 + hstepA, voffA);
            PG8_WAIT_V(8); PG8_WAIT_L(0); PG8_BAR; PG8_MMA(0, 0, At, B0); PG8_MMA(0, 1, At, B1); PG8_BAR; PG8_SCHED;
            PG8_LDA(At, 0, 1); PG8_STAGE(PG8_SB(0, 0), b2, voffB); PG8_STAGE(PG8_SB(0, 1), b2 + hstepB, voffB); PG8_STAGE(PG8_SA(0, 0), a2, voffA);
            PG8_WAIT_V(8); PG8_WAIT_L(0); PG8_BAR; PG8_MMA(1, 0, At, B0); PG8_MMA(1, 1, At, B1); PG8_BAR; PG8_SCHED;
            PG8_LDB(B0, 1, 0); PG8_LDB(B1, 1, 1); PG8_SCHED; PG8_LDA(At, 1, 0); PG8_STAGE(PG8_SA(0, 1), a2 + hstepA, voffA);
            PG8_WAIT_V(8); PG8_WAIT_L(0); PG8_BAR; PG8_MMA(0, 0, At, B0); PG8_MMA(0, 1, At, B1); PG8_BAR; PG8_SCHED;
            PG8_LDA(At, 1, 1); PG8_STAGE(PG8_SB(1, 0), b3, voffB); PG8_STAGE(PG8_SB(1, 1), b3 + hstepB, voffB); PG8_STAGE(PG8_SA(1, 0), a3, voffA);
            PG8_WAIT_V(8); PG8_WAIT_L(0); PG8_BAR; PG8_MMA(1, 0, At, B0); PG8_MMA(1, 1, At, B1); PG8_BAR; PG8_SCHED;
        }
        if (wr == 0) PG8_BAR;
        if constexpr (!Epi::AFTER_DRAIN) { E(acc, cur, wr, wc, fr, fq); }
        if (!has_next) break;
#pragma unroll
        for (int a = 0; a < 2; ++a)
#pragma unroll
            for (int b = 0; b < 2; ++b)
#pragma unroll
                for (int m = 0; m < 4; ++m)
#pragma unroll
                    for (int n = 0; n < 2; ++n) acc[a][b][m][n] = (f32x4){0.f, 0.f, 0.f, 0.f};
        cur = nxt; cA = nA; cB = nB; ++ui;
        if (wr == 1) PG8_BAR;
    }
    PG8_WAIT_V(0);
    PG8_BAR;
    if constexpr (Epi::AFTER_DRAIN) { E.fused(acc, cur, wr, wc, fr, fq, lds, wid, lane); }
#undef PG8_SA
#undef PG8_SB
#undef PG8_STAGE
#undef PG8_LDA
#undef PG8_LDB
#undef PG8_MMA
#undef PG8_WAIT_V
#undef PG8_WAIT_L
#undef PG8_BAR
#undef PG8_SCHED
}
}
namespace fk {
constexpr int T = 32768, D = 1024, S = 2048, NB = 16, NIN = 2568, NZ = 2560, NWAVES = 8, NTHR = 512;
constexpr int APAD = 65536 + 16 * 256;
constexpr float ALPHA = 1.4142135623730951f, LN_EPS = 1e-5f;
constexpr size_t MiB = 1u << 20;
constexpr size_t WS_CTL = 0, CTL_BYTES = 1 * MiB;
constexpr size_t WS_WIN = 1 * MiB, WS_WOUT = 11 * MiB, WS_WQ = 15 * MiB, WS_WKV = 19 * MiB, WS_WO = 27 * MiB, WS_WGU = 31 * MiB, WS_WD = 63 * MiB;
constexpr size_t WS_GATES = 79 * MiB, WS_EI = 80 * MiB, WS_GT = WS_EI + 256 * 1024, WS_SLOT = WS_GT + 256 * 1024, WS_DEST = WS_SLOT + 256 * 1024;
constexpr size_t WS_GATEG = 81 * MiB, WS_NST = 82 * MiB, WS_MST = 83 * MiB;
constexpr size_t WS_XB = 84 * MiB;
constexpr size_t WS_Z = 148 * MiB, WS_Y = 148 * MiB, WS_XG = 148 * MiB;
constexpr size_t WS_H = 284 * MiB, WS_YB = 318 * MiB;
constexpr size_t WS_CST = 308 * MiB, WS_MIXED = 372 * MiB;
constexpr size_t WS_Q = 276 * MiB, WS_O = 340 * MiB, WS_PSCR = 404 * MiB;
constexpr size_t WS_KV = 454 * MiB;
constexpr size_t WS_MEMB = 486 * MiB, WS_END = 494 * MiB;
constexpr int CW_BAR = 4096;
constexpr int CW_CNT = 16384;
constexpr int RING_BYTES = 131072, MISC_OFF = RING_BYTES + 320, LDS_BYTES = 147456;

struct TileOrder {
    int nM, nN, nwg, G, c;
    __device__ __forceinline__ void init(int nM_, int nN_, int G_, int c_) { nM = nM_; nN = nN_; nwg = nM * nN; G = G_; c = c_; }
    __device__ __forceinline__ bool map(int i, int& pm, int& pn) const {
        const long L = (long)i * G + c; if (L >= nwg) return false;
        int wgid = (int)L; { const int q = nwg / 8, r = nwg % 8, xcd = wgid % 8, off = wgid / 8; wgid = (xcd < r ? xcd * (q + 1) : r * (q + 1) + (xcd - r) * q) + off; }
        const int nig = 8 * nN, gid = wgid / nig, fm = gid * 8, gsz = (nM - fm) < 8 ? (nM - fm) : 8;
        pm = fm + ((wgid % nig) % gsz); pn = (wgid % nig) / gsz; return true;
    }
};
struct SchedPlain {
    TileOrder TO; const char* A; const char* B; char* O; size_t a_tile, b_tile, o_pm, o_pn;
    __device__ __forceinline__ bool next(int i, pg8::Unit& u) const {
        int pm, pn; if (!TO.map(i, pm, pn)) return false;
        u.a = A + (size_t)pm * a_tile; u.b = B + (size_t)pn * b_tile; u.o = O + (size_t)pm * o_pm + (size_t)pn * o_pn; u.aux = pm; u.aux2 = pn; return true;
    }
};
struct SchedOne { pg8::Unit u; __device__ __forceinline__ bool next(int i, pg8::Unit& o) const { if (i != 0) return false; o = u; return true; } };
struct SchedKV {
    int G, c; const char* memb; const char* wkv; char* kv;
    __device__ __forceinline__ bool next(int i, pg8::Unit& u) const {
        const int L = i * G + c; if (L >= 256) return false;
        const int l = L >> 7, kind = (L >> 6) & 1, idx = L & 63;
        const char* w = wkv + (size_t)l * 4 * MiB; char* o = kv + (size_t)l * 16 * MiB;
        if (kind == 0) { const int pm = idx >> 2, pn = idx & 3; u.a = memb + (size_t)pm * 256 * 2048; u.b = w + (size_t)pn * 256 * 2048; u.o = o + ((size_t)pm * 256 * 1024 + pn * 256) * 2; u.aux = 1024; }
        else { const int pm = idx & 3, pn = idx >> 2; u.a = w + (size_t)(1024 + pm * 256) * 2048; u.b = memb + (size_t)pn * 256 * 2048; u.o = o + 8 * MiB + ((size_t)pn * 1024 * 256 + (size_t)pm * 256 * 256) * 2; u.aux = 256; }
        u.aux2 = 0; return true;
    }
};
template <int NPN> struct SchedMoe {
    int G, c, ntot; int tstart[17];
    const char* A; size_t a_tile; const char* W; size_t w_exp, w_pn; char* O; size_t o_tile, o_pn;
    __device__ __forceinline__ void init(const unsigned* cnt  , int G_, int c_) {
        G = G_; c = c_; int s = 0;
#pragma unroll
        for (int e = 0; e < 16; ++e) { tstart[e] = s; s += __builtin_amdgcn_readfirstlane((int)((__hip_atomic_load(cnt + e * 64, RLX_AGENT) + 255u) >> 8)); }
        tstart[16] = s; ntot = s;
    }
    __device__ __forceinline__ bool next(int i, pg8::Unit& u) const {
        const int L = i * G + c; if (L >= ntot * NPN) return false;
        const int tile = L / NPN, pn = L % NPN; int e = 0;
#pragma unroll
        for (int k = 1; k < 16; ++k) e += (tile >= tstart[k]) ? 1 : 0;
        u.a = A + (size_t)tile * a_tile; u.b = W + (size_t)e * w_exp + (size_t)pn * w_pn; u.o = O + (size_t)tile * o_tile + (size_t)pn * o_pn; u.aux = tile; u.aux2 = pn; return true;
    }
};

struct EpiBf16 {
    static constexpr bool PERM = true, AFTER_DRAIN = false; int ldc; float scale;
    __device__ __forceinline__ void operator()(const f32x4 (&acc)[2][2][4][2], const pg8::Unit& u, int wr, int wc, int fr, int fq) const {
        const int ld = ldc ? ldc : u.aux; bf16* base = (bf16*)u.o + (size_t)(wr * 64 + fr) * ld + wc * 32 + 8 * fq;
#pragma unroll
        for (int ai = 0; ai < 2; ++ai)
#pragma unroll
            for (int m = 0; m < 4; ++m) { bf16* rowp = base + (size_t)(ai * 128 + m * 16) * ld;
#pragma unroll
                for (int bj = 0; bj < 2; ++bj) { const f32x4 v0 = acc[ai][bj][m][0] * scale, v1 = acc[ai][bj][m][1] * scale;
                    u32x4 w; w.x = pk2(v0[0], v0[1]); w.y = pk2(v0[2], v0[3]); w.z = pk2(v1[0], v1[1]); w.w = pk2(v1[2], v1[3]);
                    *(u32x4*)(rowp + bj * 128) = w; } }
    }
};
struct EpiRes {
    static constexpr bool PERM = false, AFTER_DRAIN = false; const float* X; float* Y;
    __device__ __forceinline__ void operator()(const f32x4 (&acc)[2][2][4][2], const pg8::Unit& u, int wr, int wc, int fr, int fq) const {
        const size_t o0 = (size_t)(u.aux * 256 + wr * 64 + fr) * 1024 + u.aux2 * 256 + wc * 32 + 4 * fq;
#pragma unroll
        for (int ai = 0; ai < 2; ++ai)
#pragma unroll
            for (int m = 0; m < 4; ++m) { const size_t o1 = o0 + (size_t)(ai * 128 + m * 16) * 1024;
#pragma unroll
                for (int bj = 0; bj < 2; ++bj)
#pragma unroll
                    for (int n = 0; n < 2; ++n) { const size_t o = o1 + bj * 128 + n * 16; const f32x4 x = *(const f32x4*)(X + o); *(f32x4*)(Y + o) = x * ALPHA + acc[ai][bj][m][n]; } }
    }
};
struct EpiSoftmax {
    static constexpr bool PERM = true, AFTER_DRAIN = true;
    __device__ __forceinline__ void fused(f32x4 (&acc)[2][2][4][2], const pg8::Unit& u, int wr, int wc, int fr, int fq, LAS unsigned char* lds, int wid, int lane) const {
        LAS float* RM = (LAS float*)lds;
        LAS float* RS = (LAS float*)(lds + 4096);
#pragma unroll
        for (int ai = 0; ai < 2; ++ai)
#pragma unroll
            for (int m = 0; m < 4; ++m) { float mx = -3.0e38f;
#pragma unroll
                for (int bj = 0; bj < 2; ++bj)
#pragma unroll
                    for (int n = 0; n < 2; ++n) { const f32x4 x = acc[ai][bj][m][n]; mx = fmaxf(mx, fmaxf(fmaxf(x[0], x[1]), fmaxf(x[2], x[3]))); }
                mx = fmaxf(mx, __shfl_xor(mx, 16)); mx = fmaxf(mx, __shfl_xor(mx, 32));
                if (fq == 0) RM[(ai * 128 + wr * 64 + m * 16 + fr) * 4 + wc] = mx; }
        LDS_WAIT(); __builtin_amdgcn_s_barrier(); asm volatile("" ::: "memory");
#pragma unroll
        for (int ai = 0; ai < 2; ++ai)
#pragma unroll
            for (int m = 0; m < 4; ++m) { const int r = ai * 128 + wr * 64 + m * 16 + fr; const f32x4 mm = *(const LAS f32x4*)(RM + r * 4);
                const float mx = fmaxf(fmaxf(mm[0], mm[1]), fmaxf(mm[2], mm[3])); float s = 0.f;
#pragma unroll
                for (int bj = 0; bj < 2; ++bj)
#pragma unroll
                    for (int n = 0; n < 2; ++n) { f32x4 x = acc[ai][bj][m][n]; x[0] = __expf(x[0] - mx); x[1] = __expf(x[1] - mx); x[2] = __expf(x[2] - mx); x[3] = __expf(x[3] - mx); acc[ai][bj][m][n] = x; s += (x[0] + x[1]) + (x[2] + x[3]); }
                s += __shfl_xor(s, 16); s += __shfl_xor(s, 32);
                if (fq == 0) RS[r * 4 + wc] = s; }
        LDS_WAIT(); __builtin_amdgcn_s_barrier(); asm volatile("" ::: "memory");
        bf16* base = (bf16*)u.o + (size_t)(wr * 64 + fr) * 256 + wc * 32 + 8 * fq;
#pragma unroll
        for (int ai = 0; ai < 2; ++ai)
#pragma unroll
            for (int m = 0; m < 4; ++m) { const int r = ai * 128 + wr * 64 + m * 16 + fr; const f32x4 ss = *(const LAS f32x4*)(RS + r * 4);
                const float inv = 1.f / ((ss[0] + ss[1]) + (ss[2] + ss[3])); bf16* rowp = base + (size_t)(ai * 128 + m * 16) * 256;
#pragma unroll
                for (int bj = 0; bj < 2; ++bj) { const f32x4 v0 = acc[ai][bj][m][0] * inv, v1 = acc[ai][bj][m][1] * inv;
                    u32x4 w; w.x = pk2(v0[0], v0[1]); w.y = pk2(v0[2], v0[3]); w.z = pk2(v1[0], v1[1]); w.w = pk2(v1[2], v1[3]);
                    *(u32x4*)(rowp + bj * 128) = w; } }
    }
};
struct EpiSiluMul {
    static constexpr bool PERM = true, AFTER_DRAIN = false;
    __device__ __forceinline__ void operator()(const f32x4 (&acc)[2][2][4][2], const pg8::Unit& u, int wr, int wc, int fr, int fq) const {
        bf16* base = (bf16*)u.o + (size_t)(wr * 64 + fr) * 256 + wc * 32 + 8 * fq;
#pragma unroll
        for (int ai = 0; ai < 2; ++ai)
#pragma unroll
            for (int m = 0; m < 4; ++m) { f32x4 h0, h1;
#pragma unroll
                for (int k = 0; k < 4; ++k) { h0[k] = silu(acc[ai][0][m][0][k]) * acc[ai][1][m][0][k]; h1[k] = silu(acc[ai][0][m][1][k]) * acc[ai][1][m][1][k]; }
                u32x4 w; w.x = pk2(h0[0], h0[1]); w.y = pk2(h0[2], h0[3]); w.z = pk2(h1[0], h1[1]); w.w = pk2(h1[2], h1[3]);
                *(u32x4*)(base + (size_t)(ai * 128 + m * 16) * 256) = w; }
    }
};
struct EpiMoeDown {
    static constexpr bool PERM = true, AFTER_DRAIN = false; const float* gateg;
    __device__ __forceinline__ void operator()(const f32x4 (&acc)[2][2][4][2], const pg8::Unit& u, int wr, int wc, int fr, int fq) const {
        bf16* base = (bf16*)u.o + (size_t)(wr * 64 + fr) * 1024 + wc * 32 + 8 * fq; const float* gp = gateg + (size_t)u.aux * 256 + wr * 64 + fr;
#pragma unroll
        for (int ai = 0; ai < 2; ++ai)
#pragma unroll
            for (int m = 0; m < 4; ++m) { const float gt = gp[ai * 128 + m * 16]; bf16* rowp = base + (size_t)(ai * 128 + m * 16) * 1024;
#pragma unroll
                for (int bj = 0; bj < 2; ++bj) { const f32x4 v0 = acc[ai][bj][m][0] * gt, v1 = acc[ai][bj][m][1] * gt;
                    u32x4 w; w.x = pk2(v0[0], v0[1]); w.y = pk2(v0[2], v0[3]); w.z = pk2(v1[0], v1[1]); w.w = pk2(v1[2], v1[3]);
                    *(u32x4*)(rowp + bj * 128) = w; } }
    }
};
}
namespace fk {
struct Args { const float* in[24]; float* out; unsigned char* ws; int ph_lo, ph_hi, bar_region, pad; };

template <class RowMap>
__device__ __forceinline__ void tr_item(const float* W, int ldw, bf16* WT, int ldt, int k0, int n0, RowMap rm, LAS float* scr, int lane) {
#pragma unroll 8
    for (int i = 0; i < 32; ++i) { const int kk = 2 * i + (lane >> 5); scr[kk * 33 + (lane & 31)] = W[(size_t)(k0 + kk) * ldw + n0 + (lane & 31)]; }
    LDS_WAIT(); asm volatile("" ::: "memory");
    const int c = lane & 7;
#pragma unroll
    for (int j = 0; j < 4; ++j) { const int n = (lane >> 3) + 8 * j; const LAS float* s = scr + (8 * c) * 33 + n;
        u32x4 o; o.x = pk2(s[0 * 33], s[1 * 33]); o.y = pk2(s[2 * 33], s[3 * 33]); o.z = pk2(s[4 * 33], s[5 * 33]); o.w = pk2(s[6 * 33], s[7 * 33]);
        *(u32x4*)(WT + (size_t)rm(n0 + n) * ldt + k0 + 8 * c) = o; }
    LDS_WAIT(); asm volatile("" ::: "memory");
}
struct RmId { __device__ __forceinline__ int operator()(int n) const { return n; } };
struct RmGate { int off; __device__ __forceinline__ int operator()(int n) const { return ((n >> 7) << 8) + (n & 127) + off; } };

__device__ __forceinline__ void p0_prologue(const Args& a, LAS unsigned char* lds, int vcu, int G) {
    int tid = threadIdx.x; asm volatile("" : "+v"(tid)); const int lane = tid & 63, wave = __builtin_amdgcn_readfirstlane(tid >> 6);
    unsigned char* ws = a.ws;
    for (int it = vcu; it < 128; it += G) {
        const int l = it >> 6, g = (it >> 4) & 3, kb = it & 15, d = tid & 127, kq = tid >> 7;
        const float* win = a.in[2] + (size_t)l * D * NIN; const float* pw = a.in[7] + (size_t)l * 65536 + (size_t)g * 16384; const float psn = a.in[8][l * 512 + g * 128 + d];
        float acc[16];
#pragma unroll
        for (int i = 0; i < 16; ++i) acc[i] = 0.f;
        const float* wrow = win + (size_t)(kb * 64 + kq * 16) * NIN + 2056 + g * 128;
        for (int c = 0; c < 128; ++c) { const float p = pw[(size_t)c * 128 + d];
#pragma unroll
            for (int i = 0; i < 16; ++i) acc[i] = fmaf(wrow[(size_t)i * NIN + c], p, acc[i]); }
        bf16* dst = (bf16*)(ws + WS_WIN) + (size_t)l * NZ * 1024 + (size_t)(2048 + g * 128 + d) * 1024 + kb * 64 + kq * 16;
        u32x4 o0, o1;
        o0.x = pk2(acc[0] * psn, acc[1] * psn); o0.y = pk2(acc[2] * psn, acc[3] * psn); o0.z = pk2(acc[4] * psn, acc[5] * psn); o0.w = pk2(acc[6] * psn, acc[7] * psn);
        o1.x = pk2(acc[8] * psn, acc[9] * psn); o1.y = pk2(acc[10] * psn, acc[11] * psn); o1.z = pk2(acc[12] * psn, acc[13] * psn); o1.w = pk2(acc[14] * psn, acc[15] * psn);
        *(u32x4*)dst = o0; *(u32x4*)(dst + 8) = o1;
    }
    LAS float* scr = (LAS float*)(lds + wave * 16384);
    const int gw = vcu * NWAVES + wave, NGW = G * NWAVES;
    constexpr int PER_LAYER = 1024 + 512 + 512 + 1024 + 512 + 3 * 2048;
    for (int it = gw; it < 2 * PER_LAYER; it += NGW) {
        const int l = it / PER_LAYER; int r = it % PER_LAYER;
        if (r < 1024) { tr_item(a.in[2] + (size_t)l * D * NIN, NIN, (bf16*)(ws + WS_WIN) + (size_t)l * NZ * 1024, 1024, (r >> 6) * 64, (r & 63) * 32, RmId{}, scr, lane); continue; } r -= 1024;
        if (r < 512) { tr_item(a.in[9] + (size_t)l * D * D, D, (bf16*)(ws + WS_WOUT) + (size_t)l * D * D, 1024, (r >> 5) * 64, (r & 31) * 32, RmId{}, scr, lane); continue; } r -= 512;
        if (r < 512) { tr_item(a.in[12] + (size_t)l * D * D, D, (bf16*)(ws + WS_WQ) + (size_t)l * D * D, 1024, (r >> 5) * 64, (r & 31) * 32, RmId{}, scr, lane); continue; } r -= 512;
        if (r < 1024) { tr_item(a.in[13] + (size_t)l * D * 2 * D, 2 * D, (bf16*)(ws + WS_WKV) + (size_t)l * 2 * D * D, 1024, (r >> 6) * 64, (r & 63) * 32, RmId{}, scr, lane); continue; } r -= 1024;
        if (r < 512) { tr_item(a.in[14] + (size_t)l * D * D, D, (bf16*)(ws + WS_WO) + (size_t)l * D * D, 1024, (r >> 5) * 64, (r & 31) * 32, RmId{}, scr, lane); continue; } r -= 512;
        if (r < 2048) { const int e = r >> 7, q = r & 127; tr_item(a.in[19] + ((size_t)l * 16 + e) * 1024 * 256, 256, (bf16*)(ws + WS_WGU) + ((size_t)l * 16 + e) * 512 * 1024, 1024, (q >> 3) * 64, (q & 7) * 32, RmGate{0}, scr, lane); continue; } r -= 2048;
        if (r < 2048) { const int e = r >> 7, q = r & 127; tr_item(a.in[20] + ((size_t)l * 16 + e) * 1024 * 256, 256, (bf16*)(ws + WS_WGU) + ((size_t)l * 16 + e) * 512 * 1024, 1024, (q >> 3) * 64, (q & 7) * 32, RmGate{128}, scr, lane); continue; } r -= 2048;
        { const int e = r >> 7, q = r & 127; tr_item(a.in[21] + ((size_t)l * 16 + e) * 256 * 1024, 1024, (bf16*)(ws + WS_WD) + ((size_t)l * 16 + e) * 1024 * 256, 256, (q >> 5) * 64, (q & 31) * 32, RmId{}, scr, lane); }
    }
    { const f32x4* src = (const f32x4*)a.in[1]; u32x2* dst = (u32x2*)(ws + WS_MEMB); const int n4 = NB * 256 * D / 4;
      for (int i = vcu * NTHR + tid; i < n4; i += G * NTHR) { const f32x4 v = src[i]; u32x2 o; o.x = pk2(v[0], v[1]); o.y = pk2(v[2], v[3]); dst[i] = o; } }
}

template <int MODE> struct RowRaw { f32x4 x[4]; u32x2 y0[MODE == 3 ? 4 : 1], y1[MODE == 3 ? 4 : 1]; };
template <int MODE>
__device__ __forceinline__ void row_load(RowRaw<MODE>& r, const float* src, const unsigned char* ws, int row, int lane) {
#pragma unroll
    for (int j = 0; j < 4; ++j) r.x[j] = *(const f32x4*)(src + (size_t)row * 1024 + 4 * lane + 256 * j);
    if (MODE == 3) {
        const int* DEST = (const int*)(ws + WS_DEST); const int d0 = DEST[2 * row], d1 = DEST[2 * row + 1];
        const bf16* YB = (const bf16*)(ws + WS_YB);
#pragma unroll
        for (int j = 0; j < (MODE == 3 ? 4 : 1); ++j) { r.y0[j] = *(const u32x2*)(YB + (size_t)d0 * 1024 + 4 * lane + 256 * j); r.y1[j] = *(const u32x2*)(YB + (size_t)d1 * 1024 + 4 * lane + 256 * j); }
    }
}
template <int MODE>
__device__ __forceinline__ void rowpass(const Args& a, LAS unsigned char* lds, int vcu, int G,
                                        const float* src, const float* lng, const float* lnb, const float* gates_w  , const float* gb_i, const float* gb_f, int layer) {
    int tid = threadIdx.x; asm volatile("" : "+v"(tid)); const int lane = tid & 63, wave = __builtin_amdgcn_readfirstlane(tid >> 6);
    unsigned char* ws = a.ws;
    float* XF = a.out; bf16* XB = (bf16*)(ws + WS_XB); float* GATES = (float*)(ws + WS_GATES);
    if (MODE == 3) src = XF;
    LAS float* WL = (LAS float*)lds;
    constexpr int NOUT = (MODE == 2) ? 16 : 8;
    const bool do_mv = (MODE == 2) || (gates_w != nullptr);
    if (MODE == 2) { const float* rw = a.in[17]; for (int idx = tid; idx < 16384; idx += NTHR) WL[(idx & 15) * 1024 + (idx >> 4)] = rw[idx]; }
    else if (do_mv) { for (int idx = tid; idx < 8192; idx += NTHR) WL[(idx & 7) * 1024 + (idx >> 3)] = gates_w[(size_t)(idx >> 3) * NIN + 2048 + (idx & 7)]; }
    LAS int* EIL = (LAS int*)(lds + 65536); LAS int* HIST = (LAS int*)(lds + 65536 + 1024); LAS int* BASE = (LAS int*)(lds + 65536 + 1024 + 64); LAS float* GTL = (LAS float*)(lds + 65536 + 2048);
    __syncthreads();
    for (int blk = vcu; blk < T / 128; blk += G) {
        if (MODE == 2) { if (tid < 16) HIST[tid] = 0; }
        const int rowb = blk * 128 + wave * 16;
        RowRaw<MODE> cur; row_load<MODE>(cur, src, ws, rowb, lane);
#pragma unroll 1
        for (int rr = 0; rr < 16; ++rr) {
            const int row = rowb + rr;
            RowRaw<MODE> nxt; row_load<MODE>(nxt, src, ws, rr < 15 ? row + 1 : row, lane);
            f32x4 v[4];
            if (MODE == 3) {
#pragma unroll
                for (int j = 0; j < 4; ++j) { const f32x4 x = cur.x[j]; const u32x2 y0 = cur.y0[MODE == 3 ? j : 0], y1 = cur.y1[MODE == 3 ? j : 0];
                    v[j][0] = x[0] * ALPHA + (bflo(y0.x) + bflo(y1.x)); v[j][1] = x[1] * ALPHA + (bfhi(y0.x) + bfhi(y1.x));
                    v[j][2] = x[2] * ALPHA + (bflo(y0.y) + bflo(y1.y)); v[j][3] = x[3] * ALPHA + (bfhi(y0.y) + bfhi(y1.y)); }
            } else {
#pragma unroll
                for (int j = 0; j < 4; ++j) v[j] = cur.x[j];
            }
            if (MODE != 0) {
                float s = 0.f;
#pragma unroll
                for (int j = 0; j < 4; ++j) s += (v[j][0] + v[j][1]) + (v[j][2] + v[j][3]);
                const float mean = wave_sum(s) * (1.f / 1024.f); float q = 0.f;
#pragma unroll
                for (int j = 0; j < 4; ++j) { v[j] = v[j] - mean; q += (v[j][0] * v[j][0] + v[j][1] * v[j][1]) + (v[j][2] * v[j][2] + v[j][3] * v[j][3]); }
                const float rstd = rsqrtf(wave_sum(q) * (1.f / 1024.f) + LN_EPS);
#pragma unroll
                for (int j = 0; j < 4; ++j) { const f32x4 gg = *(const f32x4*)(lng + 4 * lane + 256 * j), bb = *(const f32x4*)(lnb + 4 * lane + 256 * j); v[j] = v[j] * rstd * gg + bb;
                    *(f32x4*)(XF + (size_t)row * 1024 + 4 * lane + 256 * j) = v[j]; }
            }
            if (MODE != 3 || do_mv) {
#pragma unroll
                for (int j = 0; j < 4; ++j) { u32x2 o; o.x = pk2(v[j][0], v[j][1]); o.y = pk2(v[j][2], v[j][3]); *(u32x2*)(XB + (size_t)row * 1024 + 4 * lane + 256 * j) = o; }
            }
            if (do_mv) {
                float pp[NOUT];
#pragma unroll
                for (int e = 0; e < NOUT; ++e) { float p = 0.f;
#pragma unroll
                    for (int j = 0; j < 4; ++j) { const f32x4 w = *(const LAS f32x4*)(WL + e * 1024 + 4 * lane + 256 * j); p += (v[j][0] * w[0] + v[j][1] * w[1]) + (v[j][2] * w[2] + v[j][3] * w[3]); }
                    pp[e] = p; }
                float lg[NOUT]; allreduce_vec<NOUT>(pp, lg, lane);
                if (MODE == 2) {
                    const float* rb = a.in[18];
                    float bestv = 0.f, g1 = 0.f, g2 = 0.f; int e1 = 0, e2 = 0;
#pragma unroll
                    for (int g = 0; g < 4; ++g) {
                        float sc[4], sel[4];
#pragma unroll
                        for (int i = 0; i < 4; ++i) { sc[i] = 1.f / (1.f + expf(-lg[4 * g + i])); sel[i] = sc[i] + rb[4 * g + i]; }
                        int i1 = 0; float v1 = sel[0], s1 = sc[0];
#pragma unroll
                        for (int i = 1; i < 4; ++i) if (sel[i] > v1) { v1 = sel[i]; i1 = i; s1 = sc[i]; }
                        int i2 = 0; float v2 = -3.0e38f, s2 = 0.f;
#pragma unroll
                        for (int i = 0; i < 4; ++i) if (i != i1 && sel[i] > v2) { v2 = sel[i]; i2 = i; s2 = sc[i]; }
                        const float gs = v1 + v2;
                        if (g == 0 || gs > bestv) { bestv = gs; e1 = 4 * g + i1; e2 = 4 * g + i2; g1 = s1; g2 = s2; }
                    }
                    const float inv = 1.f / (g1 + g2);
                    if (lane == 0) { const int lr = wave * 16 + rr; EIL[2 * lr] = e1; EIL[2 * lr + 1] = e2; GTL[2 * lr] = g1 * inv; GTL[2 * lr + 1] = g2 * inv; }
                } else {
                    if (lane == 0) {
#pragma unroll
                        for (int e = 0; e < 4; ++e) { GATES[(size_t)row * 8 + e] = lg[e] + gb_i[e]; GATES[(size_t)row * 8 + 4 + e] = lg[4 + e] + gb_f[e]; }
                    }
                }
            }
            cur = nxt;
        }
        if (MODE == 2) {
            __syncthreads();
            int e = 0, ls = 0;
            if (tid < 256) { e = EIL[tid]; ls = atomicAdd((int*)&HIST[e], 1); }
            __syncthreads();
            if (tid < 16) BASE[tid] = (int)__hip_atomic_fetch_add((unsigned*)(ws + WS_CTL) + CW_CNT + (layer * 16 + tid) * 64, (unsigned)HIST[tid], RLX_AGENT);
            __syncthreads();
            if (tid < 256) { const int as = blk * 256 + tid; ((int*)(ws + WS_EI))[as] = e; ((int*)(ws + WS_SLOT))[as] = BASE[e] + ls; ((float*)(ws + WS_GT))[as] = GTL[tid]; }
            __syncthreads();
        }
    }
}

__device__ __forceinline__ float wave_incl_sum(float v, int lane) {
#pragma unroll
    for (int o = 1; o < 64; o <<= 1) { const float t = __shfl_up(v, o); if (lane >= o) v += t; }
    return v;
}
__device__ __forceinline__ float wave_incl_max(float v, int lane) {
#pragma unroll
    for (int o = 1; o < 64; o <<= 1) { const float t = __shfl_up(v, o); if (lane >= o) v = fmaxf(v, t); }
    return v;
}

__device__ __forceinline__ void conv8r(const u32x4 (&z)[4], const f32x4 (&w)[4][2], float (&out)[8]) {
    float acc[8];
#pragma unroll
    for (int c = 0; c < 8; ++c) acc[c] = 0.f;
#pragma unroll
    for (int j = 0; j < 4; ++j) {
        acc[0] = fmaf(bflo(z[j].x), w[j][0][0], acc[0]); acc[1] = fmaf(bfhi(z[j].x), w[j][0][1], acc[1]); acc[2] = fmaf(bflo(z[j].y), w[j][0][2], acc[2]); acc[3] = fmaf(bfhi(z[j].y), w[j][0][3], acc[3]);
        acc[4] = fmaf(bflo(z[j].z), w[j][1][0], acc[4]); acc[5] = fmaf(bfhi(z[j].z), w[j][1][1], acc[5]); acc[6] = fmaf(bflo(z[j].w), w[j][1][2], acc[6]); acc[7] = fmaf(bfhi(z[j].w), w[j][1][3], acc[7]);
    }
#pragma unroll
    for (int c = 0; c < 8; ++c) out[c] = silu(acc[c]);
}
__device__ __forceinline__ void conv_rows_load(u32x4 (&z)[4], const bf16* zrow, int tpos) {
#pragma unroll
    for (int j = 0; j < 4; ++j) { const int dt = 3 - j; z[j] = (u32x4){0u, 0u, 0u, 0u}; if (tpos - dt >= 0) z[j] = *(const u32x4*)(zrow - (size_t)dt * NZ); }
}
__device__ __forceinline__ void p2_pool_state(const Args& a, LAS unsigned char* lds, int vcu, int G, int layer) {
    int tid = threadIdx.x; asm volatile("" : "+v"(tid)); const int lane = tid & 63, wave = __builtin_amdgcn_readfirstlane(tid >> 6);
    unsigned char* ws = a.ws; const bf16* Z = (const bf16*)(ws + WS_Z); bf16* MIX = (bf16*)(ws + WS_MIXED); const float* GATES = (const float*)(ws + WS_GATES);
    { LAS bf16* U = (LAS bf16*)lds;
      for (int hb = vcu; hb < T / 64; hb += G) {
        const int row0 = hb * 64, t0 = row0 & (S - 1);
        for (int p = tid; p < 79 * 64; p += NTHR) { const int r = p >> 6, cq = p & 63; u32x4 z = (u32x4){0u, 0u, 0u, 0u};
            if (t0 + r - 15 >= 0) z = *(const u32x4*)(Z + (size_t)(row0 + r - 15) * NZ + 2048 + 8 * cq);
            *(LAS u32x4*)(U + r * 512 + 8 * cq) = z; }
        __syncthreads();
        const int ch = tid, w = 2 << (ch >> 7); float sum = 0.f;
        for (int r = 1; r < w; ++r) sum += bf2f(U[(15 - r) * 512 + ch]);
#pragma unroll 4
        for (int i = 0; i < 64; ++i) {
            const float u = bf2f(U[(15 + i) * 512 + ch]); sum += u;
            const float o = sum / (float)min(t0 + i + 1, w) - u;
            MIX[(size_t)(row0 + i) * 1024 + 512 + ch] = (bf16)f2bf(o);
            sum -= bf2f(U[(15 + i - (w - 1)) * 512 + ch]);
        }
        __syncthreads();
      } }
    { bf16* QKC = (bf16*)(ws + WS_XB); const float* cwl0 = a.in[5] + (size_t)layer * 4096; const int cg = tid & 127;
      f32x4 cw[4][2];
#pragma unroll
      for (int j = 0; j < 4; ++j) { cw[j][0] = *(const f32x4*)(cwl0 + j * 1024 + 8 * cg); cw[j][1] = *(const f32x4*)(cwl0 + j * 1024 + 8 * cg + 4); }
      const float qs = (cg < 64) ? 0.08838834764831845f : 1.f;
      for (int blk = vcu; blk < T / 128; blk += G) {
#pragma unroll 2
        for (int i = 0; i < 32; ++i) { const int row = blk * 128 + (tid >> 7) + 4 * i; u32x4 z[4]; float o[8];
            conv_rows_load(z, Z + (size_t)row * NZ + 8 * cg, row & (S - 1)); conv8r(z, cw, o);
            u32x4 w; w.x = pk2(o[0] * qs, o[1] * qs); w.y = pk2(o[2] * qs, o[3] * qs); w.z = pk2(o[4] * qs, o[5] * qs); w.w = pk2(o[6] * qs, o[7] * qs);
            *(u32x4*)(QKC + (size_t)row * 1024 + 8 * cg) = w; } } }
    constexpr int KTP = 72;
    LAS bf16* KT = (LAS bf16*)lds; LAS bf16* VT = (LAS bf16*)(lds + 128 * KTP * 2);
    const float* cwl = a.in[5] + (size_t)layer * 4096;
    bf16* CST = (bf16*)(ws + WS_CST); float* NST = (float*)(ws + WS_NST); float* MST = (float*)(ws + WS_MST);
    const int fr = lane & 15, fq = lane >> 4;
    for (int u = vcu; u < 256; u += G) {
        const int bh = u >> 2, es = u & 3, b = bh >> 2, h = bh & 3, dg = tid & 15, lt = tid >> 4;
        f32x4 cw[4][2];
#pragma unroll
        for (int j = 0; j < 4; ++j) { cw[j][0] = *(const f32x4*)(cwl + j * 1024 + 512 + h * 128 + 8 * dg); cw[j][1] = *(const f32x4*)(cwl + j * 1024 + 512 + h * 128 + 8 * dg + 4); }
        f32x4 C[2]; C[0] = (f32x4){0.f, 0.f, 0.f, 0.f}; C[1] = C[0];
        float nst = 0.f, m = 0.f;
        u32x4 kr[2][4], vr = (u32x4){0u, 0u, 0u, 0u}; float fpre, ig;
        { const int trow0 = b * S;
#pragma unroll
          for (int i = 0; i < 2; ++i) conv_rows_load(kr[i], Z + (size_t)(trow0 + lt + 32 * i) * NZ + 512 + h * 128 + 8 * dg, lt + 32 * i);
          if (tid < 256) vr = *(const u32x4*)(Z + (size_t)(trow0 + (tid >> 2)) * NZ + 1024 + h * 128 + es * 32 + 8 * (tid & 3));
          fpre = GATES[(size_t)(trow0 + lane) * 8 + 4 + h]; ig = GATES[(size_t)(trow0 + lane) * 8 + h]; }
#pragma unroll 1
        for (int c = 0; c < 32; ++c) {
            const int chunk = bh * 32 + c;
            const float bc = wave_incl_sum(logsig(fpre), lane), blast = __shfl(bc, 63);
            const float wst = blast - bc + ig, mloc = wave_max(wst), al = __expf(wst - mloc);
            const float mnew = fmaxf(blast + m, mloc), s_old = __expf(blast + m - mnew), s_new = __expf(mloc - mnew);
#pragma unroll
            for (int i = 0; i < 2; ++i) {
                const int l = lt + 32 * i; float kv[8];
                conv8r(kr[i], cw, kv);
                const float sc = __shfl(al, l);
#pragma unroll
                for (int j = 0; j < 8; ++j) KT[(8 * dg + j) * KTP + l] = (bf16)f2bf(kv[j] * sc);
            }
            if (tid < 256) { const int sidx = tid >> 2, eg = tid & 3; LAS bf16* vp = VT + (8 * eg) * KTP + sidx;
                vp[0] = (bf16)(vr.x & 0xffffu); vp[KTP] = (bf16)(vr.x >> 16); vp[2 * KTP] = (bf16)(vr.y & 0xffffu); vp[3 * KTP] = (bf16)(vr.y >> 16);
                vp[4 * KTP] = (bf16)(vr.z & 0xffffu); vp[5 * KTP] = (bf16)(vr.z >> 16); vp[6 * KTP] = (bf16)(vr.w & 0xffffu); vp[7 * KTP] = (bf16)(vr.w >> 16); }
            if (c + 1 < 32) { const int trow0 = b * S + (c + 1) * 64;
#pragma unroll
                for (int i = 0; i < 2; ++i) conv_rows_load(kr[i], Z + (size_t)(trow0 + lt + 32 * i) * NZ + 512 + h * 128 + 8 * dg, (c + 1) * 64 + lt + 32 * i);
                if (tid < 256) vr = *(const u32x4*)(Z + (size_t)(trow0 + (tid >> 2)) * NZ + 1024 + h * 128 + es * 32 + 8 * (tid & 3));
                fpre = GATES[(size_t)(trow0 + lane) * 8 + 4 + h]; ig = GATES[(size_t)(trow0 + lane) * 8 + h]; }
            __syncthreads();
            f32x4 CL[2]; CL[0] = (f32x4){0.f, 0.f, 0.f, 0.f}; CL[1] = CL[0];
#pragma unroll
            for (int kk = 0; kk < 2; ++kk) { const bf16x8 af = *(const LAS bf16x8*)(KT + (16 * wave + fr) * KTP + kk * 32 + fq * 8);
#pragma unroll
                for (int et = 0; et < 2; ++et) { const bf16x8 bfg = *(const LAS bf16x8*)(VT + (16 * et + fr) * KTP + kk * 32 + fq * 8);
                    CL[et] = __builtin_amdgcn_mfma_f32_16x16x32_bf16(af, bfg, CL[et], 0, 0, 0); } }
            float nloc = 0.f;
            if (es == 0 && tid < 128) {
#pragma unroll
                for (int q = 0; q < 8; ++q) { const u32x4 kq = *(const LAS u32x4*)(KT + tid * KTP + 8 * q);
                    nloc += (bflo(kq.x) + bfhi(kq.x)) + (bflo(kq.y) + bfhi(kq.y)) + (bflo(kq.z) + bfhi(kq.z)) + (bflo(kq.w) + bfhi(kq.w)); }
                NST[(size_t)chunk * 128 + tid] = nst;
                if (tid == 0) MST[chunk] = m;
            }
#pragma unroll
            for (int et = 0; et < 2; ++et) {
                u32x2 o; o.x = pk2(C[et][0], C[et][1]); o.y = pk2(C[et][2], C[et][3]);
                *(u32x2*)(CST + ((size_t)chunk * 128 + es * 32 + et * 16 + fr) * 128 + 16 * wave + 4 * fq) = o;
                C[et] = C[et] * s_old + CL[et] * s_new;
            }
            nst = nst * s_old + nloc * s_new; m = mnew;
            __syncthreads();
        }
    }
}

struct P3Raw { u32x4 q[2], k[2], v[2], c[4], o[2]; float fpre, ig, mprev, np; };
__device__ __forceinline__ void p3_load(P3Raw& r, const unsigned char* ws, int u, int tid, int lane) {
    const bf16* Z = (const bf16*)(ws + WS_Z); const float* GATES = (const float*)(ws + WS_GATES); const bf16* QKC = (const bf16*)(ws + WS_XB);
    const bf16* CST = (const bf16*)(ws + WS_CST); const float* NST = (const float*)(ws + WS_NST); const float* MST = (const float*)(ws + WS_MST);
    const int bh = u >> 5, c = u & 31, b = bh >> 2, h = bh & 3, trow0 = b * S + c * 64, dg = tid & 15, lt = tid >> 4;
#pragma unroll
    for (int i = 0; i < 2; ++i) { const int l = lt + 32 * i; const bf16* qr = QKC + (size_t)(trow0 + l) * 1024 + h * 128 + 8 * dg;
        r.q[i] = *(const u32x4*)qr; r.k[i] = *(const u32x4*)(qr + 512); r.v[i] = *(const u32x4*)(Z + (size_t)(trow0 + l) * NZ + 1024 + h * 128 + 8 * dg); }
#pragma unroll
    for (int i = 0; i < 4; ++i) { const int p = tid + 512 * i; r.c[i] = *(const u32x4*)(CST + ((size_t)u * 128 + (p >> 4)) * 128 + 8 * (p & 15)); }
    { const int l = tid >> 3, part = tid & 7; const bf16* zo = Z + (size_t)(trow0 + l) * NZ + 1536 + h * 128 + 16 * part; r.o[0] = *(const u32x4*)zo; r.o[1] = *(const u32x4*)(zo + 8); }
    r.fpre = GATES[(size_t)(trow0 + lane) * 8 + 4 + h]; r.ig = GATES[(size_t)(trow0 + lane) * 8 + h]; r.mprev = MST[u];
    r.np = (tid < 128) ? NST[(size_t)u * 128 + tid] : 0.f;
}
__device__ __forceinline__ void p3_mlstm_out(const Args& a, LAS unsigned char* lds, int vcu, int G, int layer) {
    int tid = threadIdx.x; asm volatile("" : "+v"(tid)); const int lane = tid & 63, wave = __builtin_amdgcn_readfirstlane(tid >> 6);
    unsigned char* ws = a.ws; bf16* MIX = (bf16*)(ws + WS_MIXED);
    const float* hng = a.in[6] + (size_t)layer * 512;
    constexpr int QP = 136, VP = 72, AP = 200, HP = 132;
    LAS bf16* QS = (LAS bf16*)lds; LAS bf16* KS = (LAS bf16*)(lds + 17408); LAS float* HB = (LAS float*)lds;
    LAS bf16* VT = (LAS bf16*)(lds + 34816); LAS bf16* CT = (LAS bf16*)(lds + 53248); LAS bf16* A2 = (LAS bf16*)(lds + 88064);
    LAS float* SU = (LAS float*)(lds + 113664); LAS float* SG = SU + 64; LAS float* SEN = SU + 128; LAS float* SDEN = SU + 192; LAS float* NP = SU + 256;
    const int fr = lane & 15, fq = lane >> 4, dg = tid & 15, lt = tid >> 4;
    P3Raw R;
    if (vcu < 2048) p3_load(R, ws, vcu, tid, lane);
#pragma unroll 1
    for (int u = vcu; u < 2048; u += G) {
        const int bh = u >> 5, b = bh >> 2, h = bh & 3, c = u & 31, trow0 = b * S + c * 64;
        const float bc = wave_incl_sum(logsig(R.fpre), lane), ul = R.ig - bc, mprev = R.mprev;
        const float gl = fmaxf(mprev, wave_incl_max(ul, lane)), inter = __expf(mprev - gl);
        if (wave == 0) { SU[lane] = ul; SG[lane] = gl; SEN[lane] = __expf(-(bc + gl)); }
        if (tid < 128) NP[tid] = R.np;
#pragma unroll
        for (int i = 0; i < 2; ++i) {
            const int l = lt + 32 * i;
            const float it = __shfl(inter, l);
            const u32x4 qw = R.q[i];
            *(LAS u32x4*)(QS + l * QP + 8 * dg) = qw;
            u32x4 o; o.x = pk2(bflo(qw.x) * it, bfhi(qw.x) * it); o.y = pk2(bflo(qw.y) * it, bfhi(qw.y) * it); o.z = pk2(bflo(qw.z) * it, bfhi(qw.z) * it); o.w = pk2(bflo(qw.w) * it, bfhi(qw.w) * it);
            *(LAS u32x4*)(A2 + l * AP + 64 + 8 * dg) = o;
            *(LAS u32x4*)(KS + l * QP + 8 * dg) = R.k[i];
            const u32x4 z = R.v[i]; LAS bf16* vp = VT + (8 * dg) * VP + l;
            vp[0] = (bf16)(z.x & 0xffffu); vp[VP] = (bf16)(z.x >> 16); vp[2 * VP] = (bf16)(z.y & 0xffffu); vp[3 * VP] = (bf16)(z.y >> 16);
            vp[4 * VP] = (bf16)(z.z & 0xffffu); vp[5 * VP] = (bf16)(z.z >> 16); vp[6 * VP] = (bf16)(z.w & 0xffffu); vp[7 * VP] = (bf16)(z.w >> 16);
        }
#pragma unroll
        for (int i = 0; i < 4; ++i) { const int p = tid + 512 * i; *(LAS u32x4*)(CT + (p >> 4) * QP + 8 * (p & 15)) = R.c[i]; }
        const u32x4 og0 = R.o[0], og1 = R.o[1];
        if (u + G < 2048) p3_load(R, ws, u + G, tid, lane);
        __syncthreads();
        { const int rt = wave >> 1, ctb = (wave & 1) * 2;
#pragma unroll
          for (int cc = 0; cc < 2; ++cc) { const int ct = ctb + cc; f32x4 acc = (f32x4){0.f, 0.f, 0.f, 0.f};
#pragma unroll
            for (int kk = 0; kk < 4; ++kk) { const bf16x8 af = *(const LAS bf16x8*)(QS + (16 * rt + fr) * QP + kk * 32 + fq * 8), bfg = *(const LAS bf16x8*)(KS + (16 * ct + fr) * QP + kk * 32 + fq * 8);
                acc = __builtin_amdgcn_mfma_f32_16x16x32_bf16(af, bfg, acc, 0, 0, 0); }
            const int sidx = 16 * ct + fr; const float us = SU[sidx];
#pragma unroll
            for (int r = 0; r < 4; ++r) { const int l = 16 * rt + 4 * fq + r; const float p = (sidx <= l) ? acc[r] * __expf(us - SG[l]) : 0.f; A2[l * AP + sidx] = (bf16)f2bf(p); } } }
        __syncthreads();
        f32x4 nacc[4];
        { const int rt = wave >> 1, ctb = (wave & 1) * 4;
#pragma unroll
          for (int j = 0; j < 4; ++j) nacc[j] = (f32x4){0.f, 0.f, 0.f, 0.f};
#pragma unroll
          for (int kk = 0; kk < 6; ++kk) { const bf16x8 af = *(const LAS bf16x8*)(A2 + (16 * rt + fr) * AP + kk * 32 + fq * 8);
#pragma unroll
            for (int j = 0; j < 4; ++j) { const int ct = ctb + j;
                const bf16x8 bfg = (kk < 2) ? *(const LAS bf16x8*)(VT + (16 * ct + fr) * VP + kk * 32 + fq * 8) : *(const LAS bf16x8*)(CT + (16 * ct + fr) * QP + (kk - 2) * 32 + fq * 8);
                nacc[j] = __builtin_amdgcn_mfma_f32_16x16x32_bf16(af, bfg, nacc[j], 0, 0, 0); } } }
        { const int l = tid >> 3, part = tid & 7; float dsum = 0.f;
#pragma unroll
          for (int q = 0; q < 3; ++q) { const int j0 = part * 24 + q * 8; const u32x4 av = *(const LAS u32x4*)(A2 + l * AP + j0);
            float w[8];
#pragma unroll
            for (int j = 0; j < 8; ++j) w[j] = (j0 + j < 64) ? 1.f : NP[j0 + j - 64];
            dsum += bflo(av.x) * w[0] + bfhi(av.x) * w[1] + bflo(av.y) * w[2] + bfhi(av.y) * w[3] + bflo(av.z) * w[4] + bfhi(av.z) * w[5] + bflo(av.w) * w[6] + bfhi(av.w) * w[7]; }
          dsum = group8_sum(dsum);
          if (part == 0) SDEN[l] = dsum; }
        __syncthreads();
        { const int rt = wave >> 1, ctb = (wave & 1) * 4;
#pragma unroll
          for (int r = 0; r < 4; ++r) { const int l = 16 * rt + 4 * fq + r; const float dn = 1.f / fmaxf(fabsf(SDEN[l]), SEN[l]);
#pragma unroll
            for (int j = 0; j < 4; ++j) HB[l * HP + 16 * (ctb + j) + fr] = nacc[j][r] * dn; } }
        __syncthreads();
        { const int l = tid >> 3, part = tid & 7; f32x4 hv[4]; float sm = 0.f;
#pragma unroll
          for (int q = 0; q < 4; ++q) { hv[q] = *(const LAS f32x4*)(HB + l * HP + 16 * part + 4 * q); sm += (hv[q][0] + hv[q][1]) + (hv[q][2] + hv[q][3]); }
          const float mean = group8_sum(sm) * (1.f / 128.f); float qq = 0.f;
#pragma unroll
          for (int q = 0; q < 4; ++q) { hv[q] = hv[q] - mean; qq += (hv[q][0] * hv[q][0] + hv[q][1] * hv[q][1]) + (hv[q][2] * hv[q][2] + hv[q][3] * hv[q][3]); }
          const float rs = rsqrtf(group8_sum(qq) * (1.f / 128.f) + LN_EPS);
          const float* gp = hng + h * 128 + 16 * part; u32x4 w0, w1;
          { const f32x4 g0 = *(const f32x4*)gp, g1 = *(const f32x4*)(gp + 4), g2 = *(const f32x4*)(gp + 8), g3 = *(const f32x4*)(gp + 12);
            w0.x = pk2(hv[0][0] * rs * g0[0] * sigm(bflo(og0.x)), hv[0][1] * rs * g0[1] * sigm(bfhi(og0.x))); w0.y = pk2(hv[0][2] * rs * g0[2] * sigm(bflo(og0.y)), hv[0][3] * rs * g0[3] * sigm(bfhi(og0.y)));
            w0.z = pk2(hv[1][0] * rs * g1[0] * sigm(bflo(og0.z)), hv[1][1] * rs * g1[1] * sigm(bfhi(og0.z))); w0.w = pk2(hv[1][2] * rs * g1[2] * sigm(bflo(og0.w)), hv[1][3] * rs * g1[3] * sigm(bfhi(og0.w)));
            w1.x = pk2(hv[2][0] * rs * g2[0] * sigm(bflo(og1.x)), hv[2][1] * rs * g2[1] * sigm(bfhi(og1.x))); w1.y = pk2(hv[2][2] * rs * g2[2] * sigm(bflo(og1.y)), hv[2][3] * rs * g2[3] * sigm(bfhi(og1.y)));
            w1.z = pk2(hv[3][0] * rs * g3[0] * sigm(bflo(og1.z)), hv[3][1] * rs * g3[1] * sigm(bfhi(og1.z))); w1.w = pk2(hv[3][2] * rs * g3[2] * sigm(bflo(og1.w)), hv[3][3] * rs * g3[3] * sigm(bfhi(og1.w))); }
          bf16* mo = MIX + (size_t)(trow0 + l) * 1024 + h * 128 + 16 * part; *(u32x4*)mo = w0; *(u32x4*)(mo + 8) = w1; }
        __syncthreads();
    }
}

__device__ __forceinline__ void p10a_gather(const Args& a, LAS unsigned char* lds, int vcu, int G, int layer) {
    int tid = threadIdx.x; asm volatile("" : "+v"(tid)); const int lane = tid & 63, wave = __builtin_amdgcn_readfirstlane(tid >> 6);
    unsigned char* ws = a.ws; const unsigned* cnt = (const unsigned*)(ws + WS_CTL) + CW_CNT + layer * 16 * 64;
    LAS int* PST = (LAS int*)lds; LAS int* DL = (LAS int*)(lds + 256);
    if (tid == 0) { int s = 0; for (int e = 0; e < 16; ++e) { PST[e] = s; s += (int)(((__hip_atomic_load(cnt + e * 64, RLX_AGENT) + 255u) >> 8) << 8); } }
    __syncthreads();
    const bf16* XB = (const bf16*)(ws + WS_XB); bf16* XG = (bf16*)(ws + WS_XG);
    for (int blk = vcu; blk < T / 128; blk += G) {
        if (tid < 256) { const int as = blk * 256 + tid; const int e = ((const int*)(ws + WS_EI))[as]; const int d = PST[e] + ((const int*)(ws + WS_SLOT))[as];
            ((int*)(ws + WS_DEST))[as] = d; ((float*)(ws + WS_GATEG))[d] = ((const float*)(ws + WS_GT))[as]; DL[tid] = d; }
        __syncthreads();
        for (int r = wave; r < 256; r += NWAVES) { const int row = blk * 128 + (r >> 1), d = DL[r];
            const u32x4* s = (const u32x4*)(XB + (size_t)row * 1024); u32x4* o = (u32x4*)(XG + (size_t)d * 1024);
            o[lane] = s[lane]; o[lane + 64] = s[lane + 64]; }
        __syncthreads();
    }
}

__global__ void __launch_bounds__(NTHR, 2) mk_fwd(Args a) {
    extern __shared__ __attribute__((aligned(16))) unsigned char lds_[];
    LAS unsigned char* lds = (LAS unsigned char*)lds_;
    const int tid = threadIdx.x, lane = tid & 63, wave = __builtin_amdgcn_readfirstlane(tid >> 6);
    const int G = gridDim.x; const int bx = blockIdx.x; const int vcu = (G % 8 == 0) ? (bx % 8) * (G / 8) + bx / 8 : bx;
    unsigned char* ws = a.ws;
    volatile LAS unsigned* MISC = (volatile LAS unsigned*)(lds + MISC_OFF);
    if (tid < 32) MISC[tid] = 0u;
    __syncthreads();
    XcdBarrier bar; bar.bar = (unsigned*)(ws + WS_CTL) + CW_BAR + a.bar_region * XCD_BAR_WORDS; bar.x = 0; bar.st = nullptr;
    const bool multi = (a.ph_hi - a.ph_lo) > 1;
    if (multi) bar = xcd_barrier_post((unsigned*)(ws + WS_CTL) + CW_BAR + a.bar_region * XCD_BAR_WORDS, MISC + 8);
    const int lo = a.ph_lo, hi = a.ph_hi;
#ifndef PHMASK
#define PHMASK 0xFFFFFFFFu
#endif
#define PHK(j) ((PHMASK >> (j)) & 1u)
#define IN(k) (lo <= (k) && (k) < hi)
#define SEAM(k) do { if (IN(k) && IN((k) + 1)) xcd_barrier(bar); } while (0)

    if (PHK(0) && IN(0)) { p0_prologue(a, lds, vcu, G);
        rowpass<0>(a, lds, vcu, G, a.in[0], nullptr, nullptr, a.in[2], a.in[3], a.in[4], 0); }
    SEAM(0);
#pragma unroll 1
    for (int l = 0; l < 2; ++l) {
        const int pb = 1 + 13 * l;
        const float* xres = (l == 0) ? a.in[0] : a.out;
        if (PHK(1) && IN(pb + 0)) {
            SchedPlain Sz; Sz.TO.init(T / 256, NZ / 256, G, bx); Sz.A = (const char*)(ws + WS_XB); Sz.B = (const char*)(ws + WS_WIN + (size_t)l * NZ * 1024 * 2); Sz.O = (char*)(ws + WS_Z);
            Sz.a_tile = 256 * 1024 * 2; Sz.b_tile = 256 * 1024 * 2; Sz.o_pm = (size_t)256 * NZ * 2; Sz.o_pn = 256 * 2;
            pg8::gemm_phase(lds, pg8::Gemm{1024, 1024, 1024}, Sz, EpiBf16{NZ, 1.f});
            if (l == 0) { __syncthreads(); SchedKV Sk{G, vcu, (const char*)(ws + WS_MEMB), (const char*)(ws + WS_WKV), (char*)(ws + WS_KV)};
                pg8::gemm_phase(lds, pg8::Gemm{1024, 1024, 1024}, Sk, EpiBf16{0, 1.f}); }
        }
        SEAM(pb + 0);
        if (PHK(2) && IN(pb + 1)) p2_pool_state(a, lds, vcu, G, l);
        SEAM(pb + 1);
        if (PHK(3) && IN(pb + 2)) p3_mlstm_out(a, lds, vcu, G, l);
        SEAM(pb + 2);
        if (PHK(4) && IN(pb + 3)) {
            SchedPlain Sp; Sp.TO.init(T / 256, 4, G, bx); Sp.A = (const char*)(ws + WS_MIXED); Sp.B = (const char*)(ws + WS_WOUT + (size_t)l * 2 * MiB); Sp.O = nullptr;
            Sp.a_tile = 256 * 1024 * 2; Sp.b_tile = 256 * 1024 * 2; Sp.o_pm = 0; Sp.o_pn = 0;
            pg8::gemm_phase(lds, pg8::Gemm{1024, 1024, 1024}, Sp, EpiRes{xres, (float*)(ws + WS_Y)});
        }
        SEAM(pb + 3);
        if (PHK(5) && IN(pb + 4)) rowpass<1>(a, lds, vcu, G, (const float*)(ws + WS_Y), a.in[10] + l * D, a.in[11] + l * D, nullptr, nullptr, nullptr, l);
        SEAM(pb + 4);
        if (PHK(6) && IN(pb + 5)) {
            SchedPlain Sp; Sp.TO.init(T / 256, 4, G, bx); Sp.A = (const char*)(ws + WS_XB); Sp.B = (const char*)(ws + WS_WQ + (size_t)l * 2 * MiB); Sp.O = (char*)(ws + WS_Q);
            Sp.a_tile = 256 * 1024 * 2; Sp.b_tile = 256 * 1024 * 2; Sp.o_pm = 256 * 1024 * 2; Sp.o_pn = 256 * 2;
            pg8::gemm_phase(lds, pg8::Gemm{1024, 1024, 1024}, Sp, EpiBf16{1024, 0.0625f});
        }
        SEAM(pb + 5);
        if (PHK(7) && IN(pb + 6)) {
            char* pscr = (char*)(ws + WS_PSCR) + (size_t)bx * 131072;
            const char* Kb = (const char*)(ws + WS_KV + (size_t)l * 16 * MiB); const char* VTb = Kb + 8 * MiB;
            for (int L = vcu; L < 512; L += G) {
                const int b = L >> 5, h = (L >> 3) & 3, qt = L & 7;
                SchedOne S1; S1.u.a = (const char*)(ws + WS_Q) + ((size_t)(b * S + qt * 256) * 1024 + h * 256) * 2; S1.u.b = Kb + ((size_t)(b * 256) * 1024 + h * 256) * 2; S1.u.o = pscr; S1.u.aux = 0; S1.u.aux2 = 0;
                pg8::gemm_phase(lds, pg8::Gemm{1024, 1024, 256}, S1, EpiSoftmax{});
                VM_WAIT(); __syncthreads();
                if (tid == 0) { __builtin_amdgcn_fence(__ATOMIC_ACQUIRE, "agent"); VM_WAIT(); }
                __syncthreads();
                SchedOne S2; S2.u.a = pscr; S2.u.b = VTb + ((size_t)b * 1024 * 256 + (size_t)h * 256 * 256) * 2; S2.u.o = (char*)(ws + WS_O) + ((size_t)(b * S + qt * 256) * 1024 + h * 256) * 2; S2.u.aux = 0; S2.u.aux2 = 0;
                pg8::gemm_phase(lds, pg8::Gemm{256, 256, 256}, S2, EpiBf16{1024, 1.f});
                __syncthreads();
            }
        }
        SEAM(pb + 6);
        if (PHK(8) && IN(pb + 7)) {
            SchedPlain Sp; Sp.TO.init(T / 256, 4, G, bx); Sp.A = (const char*)(ws + WS_O); Sp.B = (const char*)(ws + WS_WO + (size_t)l * 2 * MiB); Sp.O = nullptr;
            Sp.a_tile = 256 * 1024 * 2; Sp.b_tile = 256 * 1024 * 2; Sp.o_pm = 0; Sp.o_pn = 0;
            pg8::gemm_phase(lds, pg8::Gemm{1024, 1024, 1024}, Sp, EpiRes{a.out, (float*)(ws + WS_Y)});
        }
        SEAM(pb + 7);
        if (PHK(9) && IN(pb + 8)) rowpass<2>(a, lds, vcu, G, (const float*)(ws + WS_Y), a.in[15] + l * D, a.in[16] + l * D, nullptr, nullptr, nullptr, l);
        SEAM(pb + 8);
        if (PHK(10) && IN(pb + 9)) p10a_gather(a, lds, vcu, G, l);
        SEAM(pb + 9);
        if (PHK(11) && IN(pb + 10)) {
            SchedMoe<2> Sm; Sm.init((const unsigned*)(ws + WS_CTL) + CW_CNT + l * 16 * 64, G, vcu);
            Sm.A = (const char*)(ws + WS_XG); Sm.a_tile = 256 * 1024 * 2; Sm.W = (const char*)(ws + WS_WGU + (size_t)l * 16 * MiB); Sm.w_exp = 512 * 1024 * 2; Sm.w_pn = 256 * 1024 * 2;
            Sm.O = (char*)(ws + WS_H); Sm.o_tile = 256 * 256 * 2; Sm.o_pn = 128 * 2;
            pg8::gemm_phase(lds, pg8::Gemm{1024, 1024, 1024}, Sm, EpiSiluMul{});
        }
        SEAM(pb + 10);
        if (PHK(12) && IN(pb + 11)) {
            SchedMoe<4> Sm; Sm.init((const unsigned*)(ws + WS_CTL) + CW_CNT + l * 16 * 64, G, vcu);
            Sm.A = (const char*)(ws + WS_H); Sm.a_tile = 256 * 256 * 2; Sm.W = (const char*)(ws + WS_WD + (size_t)l * 8 * MiB); Sm.w_exp = 1024 * 256 * 2; Sm.w_pn = 256 * 256 * 2;
            Sm.O = (char*)(ws + WS_YB); Sm.o_tile = 256 * 1024 * 2; Sm.o_pn = 256 * 2;
            pg8::gemm_phase(lds, pg8::Gemm{256, 256, 256}, Sm, EpiMoeDown{(const float*)(ws + WS_GATEG)});
        }
        SEAM(pb + 11);
        if (PHK(13) && IN(pb + 12)) {
            if (l == 0) rowpass<3>(a, lds, vcu, G, nullptr, a.in[22] + l * D, a.in[23] + l * D, a.in[2] + (size_t)1 * D * NIN, a.in[3] + 4, a.in[4] + 4, l);
            else rowpass<3>(a, lds, vcu, G, nullptr, a.in[22] + l * D, a.in[23] + l * D, nullptr, nullptr, nullptr, l);
        }
        SEAM(pb + 12);
    }
#undef IN
#undef SEAM
}
constexpr int NPHASES = 27;
}
#ifndef KMODE
#define KMODE 1
#endif
static int fast_grid() {
    static int grid = 0;
    if (grid == 0) {
        int dev = 0, cus = 0, per_cu = 0;
        if (hipGetDevice(&dev) != hipSuccess || hipDeviceGetAttribute(&cus, hipDeviceAttributeMultiprocessorCount, dev) != hipSuccess) { fprintf(stderr, "kernel_launch: device query failed\n"); grid = -1; return grid; }
        if (hipFuncSetAttribute((const void*)fk::mk_fwd, hipFuncAttributeMaxDynamicSharedMemorySize, fk::LDS_BYTES) != hipSuccess) { fprintf(stderr, "kernel_launch: hipFuncSetAttribute failed\n"); grid = -1; return grid; }
        if (hipOccupancyMaxActiveBlocksPerMultiprocessor(&per_cu, (const void*)fk::mk_fwd, fk::NTHR, fk::LDS_BYTES) != hipSuccess || per_cu < 1) { fprintf(stderr, "kernel_launch: occupancy query says %d blocks/CU\n", per_cu); (void)hipGetLastError(); grid = -1; return grid; }
        grid = cus;
        if (grid > 256) grid = 256;
        if (grid % 8) grid -= grid % 8;
    }
    return grid;
}
static void fast_launch(hipStream_t st, const fk::Args& a0, int lo, int hi, int region = 0) {
    const int grid = fast_grid(); if (grid <= 0) return;
    fk::Args a = a0; a.ph_lo = lo; a.ph_hi = hi; a.bar_region = region; a.pad = 0;
    hipLaunchKernelGGL(fk::mk_fwd, dim3(grid), dim3(fk::NTHR), fk::LDS_BYTES, st, a);
    const hipError_t le = hipPeekAtLastError();
    if (le != hipSuccess) fprintf(stderr, "kernel_launch: launch [%d,%d) failed: %s\n", lo, hi, hipGetErrorName(le));
}
extern "C" void kernel_launch(void* const* d_in, const int* in_sizes, int n_in, void* d_out, int out_size, void* d_ws, size_t ws_size, hipStream_t stream) {
    if (n_in != 24 || out_size != slow::T * slow::D || ws_size < (size_t)501 * (1u << 20)) { fprintf(stderr, "kernel_launch: unexpected shapes n_in=%d out=%d ws=%zu\n", n_in, out_size, ws_size); return; }
    fk::Args a{};
    for (int i = 0; i < 24; ++i) a.in[i] = (const float*)d_in[i];
    a.out = (float*)d_out; a.ws = (unsigned char*)d_ws;
#if KMODE == 0
    slow::forward(stream, d_in, (float*)d_out, d_ws);
#elif KMODE == 1
    (void)hipMemsetAsync((char*)d_ws + fk::WS_CTL, 0, fk::CTL_BYTES, stream);
    fast_launch(stream, a, 0, fk::NPHASES);
#elif KMODE == 2
    (void)hipMemsetAsync((char*)d_ws + fk::WS_CTL, 0, fk::CTL_BYTES, stream);
    for (int p = 0; p < fk::NPHASES; ++p) fast_launch(stream, a, p, p + 1);
#elif KMODE == 4
    (void)hipMemsetAsync((char*)d_ws + fk::WS_CTL, 0, fk::CTL_BYTES, stream);
    if (PROBE_K > 0) fast_launch(stream, a, 0, PROBE_K, 0);
    for (int r = 0; r <= PROBE_N; ++r) fast_launch(stream, a, PROBE_K, PROBE_K + 1, 0);
    if (PROBE_K + 1 < fk::NPHASES) fast_launch(stream, a, PROBE_K + 1, fk::NPHASES, 1);
#else
    HYBRID_SEQUENCE
#endif
}
```
